# Optimizing an MI355X kernel written in HIP

```python
import jax, jax.numpy as jnp
from jax import lax
import numpy as np

D_MODEL = 1024
BATCH = 2
SEQ = 8192
DEPTH = 2
DEC_BATCH = 128
DEC_SEQ = 1
PAST_LEN = 2048
PAGE_SIZE = 128

RET_HEADS = 4
RET_DK = 128
RET_DV = 256
RET_CHUNK = 128
RET_QK = RET_HEADS * RET_DK
RET_V = RET_HEADS * RET_DV
ATT_GROUPS = ((128, 1), (512, 4), (2048, 16))
N_GROUPS = 3
HEADS_PER_GROUP = 4
ATT_HEADS = N_GROUPS * HEADS_PER_GROUP
HEAD_DIM = 64
ATT_BLOCK = 128
ATT_W = ATT_HEADS * HEAD_DIM
ATT_OUT = HEADS_PER_GROUP * HEAD_DIM
D_FF = -(-8 * D_MODEL // (3 * 256)) * 256
COL_SIZES = (RET_QK, RET_QK, RET_V, RET_V, ATT_W, ATT_W, ATT_W, D_MODEL, D_MODEL)
D_IN = 2 * RET_QK + 2 * RET_V + 3 * ATT_W + 2 * D_MODEL
RMS_EPS = 1e-6
GN_EPS = 1e-5

kernel_name = 'retention_dilated_attn_hybrid_step'


def _rms_norm(x, g):
    x32 = x.astype(jnp.float32)
    y = x32 * lax.rsqrt(jnp.mean(x32 * x32, axis=-1, keepdims=True) + RMS_EPS)
    return (y * g.astype(jnp.float32)).astype(x.dtype)


def _log_gamma():
    return jnp.log1p(-jnp.exp2(-5.0 - jnp.arange(RET_HEADS, dtype=jnp.float32)))


def _alibi_slopes():
    return jnp.exp2(-8.0 * (jnp.arange(ATT_HEADS, dtype=jnp.float32) + 1.0) / ATT_HEADS)


def _retention_chunk(q, k, v, s0, log_gamma):
    c = q.shape[1]
    idx = jnp.arange(c, dtype=jnp.float32)
    diff = idx[:, None] - idx[None, :]
    decay = jnp.where(diff >= 0, jnp.exp(jnp.maximum(diff, 0.0)[None] * log_gamma[:, None, None]), 0.0)
    scores = jnp.einsum('nihd,njhd->nhij', q, k) * decay[None]
    intra = jnp.einsum('nhij,njhv->nihv', scores, v)
    inner = jnp.exp((idx + 1.0)[:, None] * log_gamma[None, :])
    cross = jnp.einsum('nihd,nhdv->nihv', q, s0) * inner[None, :, :, None]
    tail = jnp.exp((c - 1.0 - idx)[:, None] * log_gamma[None, :])
    s1 = s0 * jnp.exp(c * log_gamma)[None, :, None, None] + jnp.einsum(
        'njhd,njhv->nhdv', k * tail[None, :, :, None], v)
    return intra + cross, s1


def _retention(q, k, v, s0):
    n, t = q.shape[:2]
    chunk = RET_CHUNK if t % RET_CHUNK == 0 else t
    nc = t // chunk
    log_gamma = _log_gamma()

    def split(a):
        return a.reshape(n, nc, chunk, *a.shape[2:]).swapaxes(0, 1)

    def step(s, inp):
        o, s = _retention_chunk(inp[0], inp[1], inp[2], s, log_gamma)
        return s, o

    s_final, o = lax.scan(step, s0, (split(q), split(k), split(v)))
    o = o.swapaxes(0, 1).reshape(n, t, RET_HEADS, RET_DV)
    return o, s_final


def _dilated_group_prompt(q, k, v, slopes, window, dilation):
    b, t, h, dh = q.shape
    span = dilation * ATT_BLOCK
    tp = -(-t // span) * span
    lres = tp // dilation
    nb = lres // ATT_BLOCK

    def arrange(a):
        a = jnp.pad(a, ((0, 0), (0, tp - t), (0, 0), (0, 0)))
        a = a.reshape(b, lres, dilation, h, dh).swapaxes(1, 2)
        return a.reshape(b, dilation, nb, ATT_BLOCK, h, dh)

    def with_prev(a):
        prev = jnp.pad(a, ((0, 0), (0, 0), (1, 0), (0, 0), (0, 0), (0, 0)))[:, :, :-1]
        return jnp.concatenate([prev, a], axis=3)

    qb = arrange(q)
    kk = with_prev(arrange(k))
    vv = with_prev(arrange(v))
    steps = window // dilation
    qi = jnp.arange(ATT_BLOCK)[:, None]
    kj = jnp.arange(2 * ATT_BLOCK)[None, :]
    dist = qi + ATT_BLOCK - kj
    blk = jnp.arange(nb)[:, None, None]
    valid = ((dist >= 0) & (dist <= steps))[None] & ((blk > 0) | (kj >= ATT_BLOCK)[None])
    s = jnp.einsum('brnihd,brnjhd->brnhij', qb, kk) * (HEAD_DIM ** -0.5)
    s = s - slopes[:, None, None] * (dist * dilation).astype(jnp.float32)[None]
    s = jnp.where(valid[None, None, :, None], s, -jnp.inf)
    m = jnp.max(s, axis=-1, keepdims=True)
    p = jnp.exp(s - m)
    l = jnp.sum(p, axis=-1, keepdims=True)
    o = jnp.einsum('brnhij,brnjhd->brnihd', p / l, vv)
    lse = (m + jnp.log(l))[..., 0].swapaxes(3, 4)
    o = o.reshape(b, dilation, lres, h, dh).swapaxes(1, 2).reshape(b, tp, h, dh)[:, :t]
    lse = lse.reshape(b, dilation, lres, h).swapaxes(1, 2).reshape(b, tp, h)[:, :t]
    return o, lse


def _dilated_group_sample(q, k_new, v_new, kv_buf, slopes, window, dilation):
    wlen = kv_buf.shape[1]
    s_new = q.shape[1]
    buf = kv_buf.astype(jnp.float32)
    keys = jnp.concatenate([buf[:, :, 0], k_new], axis=1)
    vals = jnp.concatenate([buf[:, :, 1], v_new], axis=1)
    steps = window // dilation
    j = jnp.arange(steps + 1)
    idx = wlen + jnp.arange(s_new)[:, None] - dilation * j[None, :]
    valid = idx >= 0
    idx = jnp.clip(idx, 0)
    kg = jnp.take(keys, idx, axis=1)
    vg = jnp.take(vals, idx, axis=1)
    s = jnp.einsum('nshd,nsjhd->nshj', q, kg) * (HEAD_DIM ** -0.5)
    s = s - slopes[:, None] * (dilation * j).astype(jnp.float32)[None, :]
    s = jnp.where(valid[None, :, None, :], s, -jnp.inf)
    lse = jax.nn.logsumexp(s, axis=-1)
    p = jnp.exp(s - lse[..., None])
    o = jnp.einsum('nshj,nsjhd->nshd', p, vg)
    return o, lse


def _token_mix(hn, w_in, w_ret_branch, w_att_branch, w_out, ret_s0, kv_bufs):
    f32 = jnp.float32
    n, t = hn.shape[:2]
    proj = hn @ w_in
    rq, rk, rv, rg, aq, ak, av, gr, ga = jnp.split(proj, np.cumsum(COL_SIZES)[:-1].tolist(), axis=-1)
    rq = rq.reshape(n, t, RET_HEADS, RET_DK).astype(f32) * (RET_DK ** -0.5)
    rk = rk.reshape(n, t, RET_HEADS, RET_DK).astype(f32)
    rv = rv.reshape(n, t, RET_HEADS, RET_DV).astype(f32)
    ro, ret_s1 = _retention(rq, rk, rv, ret_s0)
    mu = jnp.mean(ro, axis=-1, keepdims=True)
    var = jnp.mean(jnp.square(ro - mu), axis=-1, keepdims=True)
    ro = (ro - mu) * lax.rsqrt(var + GN_EPS)
    ro = (ro.reshape(n, t, RET_V) * jax.nn.silu(rg.astype(f32))).astype(hn.dtype)
    r_branch = ro @ w_ret_branch
    aq = aq.reshape(n, t, N_GROUPS, HEADS_PER_GROUP, HEAD_DIM)
    ak = ak.reshape(n, t, N_GROUPS, HEADS_PER_GROUP, HEAD_DIM)
    av = av.reshape(n, t, N_GROUPS, HEADS_PER_GROUP, HEAD_DIM)
    slopes = _alibi_slopes().reshape(N_GROUPS, HEADS_PER_GROUP)
    outs, lses, new_kv = [], [], []
    for g, (win, dil) in enumerate(ATT_GROUPS):
        qg = aq[:, :, g].astype(f32)
        kg = ak[:, :, g].astype(f32)
        vg = av[:, :, g].astype(f32)
        if kv_bufs is None:
            o, lse = _dilated_group_prompt(qg, kg, vg, slopes[g], win, dil)
            keep = min(win, t)
            new_kv.append(jnp.stack([ak[:, t - keep:, g], av[:, t - keep:, g]], axis=2))
        else:
            o, lse = _dilated_group_sample(qg, kg, vg, kv_bufs[g], slopes[g], win, dil)
            new_kv.append(jnp.stack([ak[:, :, g], av[:, :, g]], axis=2))
        outs.append(o)
        lses.append(lse)
    wgt = jax.nn.softmax(jnp.stack(lses, axis=0), axis=0)
    ao = jnp.einsum('gnth,gnthd->nthd', wgt, jnp.stack(outs, axis=0))
    a_branch = ao.reshape(n, t, ATT_OUT).astype(hn.dtype) @ w_att_branch
    merged = jax.nn.sigmoid(gr) * r_branch + jax.nn.sigmoid(ga) * a_branch
    return merged @ w_out, ret_s1, new_kv


def _trunk(x, ret_states, kv_caches, norm_mix, w_in, w_ret_branch, w_att_branch, w_out,
           norm_ffn, w_gate_up, w_down, norm_final):
    n = x.shape[0]
    rets, kvs = [], []
    for l in range(DEPTH):
        if ret_states is None:
            s0 = jnp.zeros((n, RET_HEADS, RET_DK, RET_DV), jnp.float32)
            bufs = None
        else:
            s0 = ret_states[l].astype(jnp.float32)
            bufs = [c[l] for c in kv_caches]
        hn = _rms_norm(x, norm_mix[l])
        y, s1, kv = _token_mix(hn, w_in[l], w_ret_branch[l], w_att_branch[l], w_out[l], s0, bufs)
        x = x + y
        hn = _rms_norm(x, norm_ffn[l])
        gate, up = jnp.split(hn @ w_gate_up[l], 2, axis=-1)
        x = x + (jax.nn.silu(gate) * up) @ w_down[l]
        rets.append(s1.astype(x.dtype))
        kvs.append(kv)
    y = _rms_norm(x, norm_final)
    ret_out = jnp.stack(rets, axis=0)
    kv_out = [jnp.stack([kvs[l][g] for l in range(DEPTH)], axis=0) for g in range(N_GROUPS)]
    return y, ret_out, kv_out


def setup_inputs(seed: int = 0) -> dict:
    key = jax.random.key(seed)
    ks = jax.random.split(key, 16)
    f32 = jnp.float32
    nrm = jax.random.normal
    wl = [min(w, PAST_LEN) for (w, _) in ATT_GROUPS]
    return {
        'x_prompt': nrm(ks[0], (BATCH, SEQ, D_MODEL), f32),
        'x_sample': nrm(ks[1], (DEC_BATCH, DEC_SEQ, D_MODEL), f32),
        'state_ret': nrm(ks[2], (DEPTH, DEC_BATCH, RET_HEADS, RET_DK, RET_DV), f32),
        'cache_kv_w128': nrm(ks[3], (DEPTH, DEC_BATCH, wl[0], 2, HEADS_PER_GROUP, HEAD_DIM), f32),
        'cache_kv_w512': nrm(ks[4], (DEPTH, DEC_BATCH, wl[1], 2, HEADS_PER_GROUP, HEAD_DIM), f32),
        'cache_kv_w2048': nrm(ks[5], (DEPTH, DEC_BATCH, wl[2], 2, HEADS_PER_GROUP, HEAD_DIM), f32),
        'norm_mix': 1.0 + 0.01 * nrm(ks[6], (DEPTH, D_MODEL), f32),
        'w_in': nrm(ks[7], (DEPTH, D_MODEL, D_IN), f32) * D_MODEL ** -0.5,
        'w_ret_branch': nrm(ks[8], (DEPTH, RET_V, D_MODEL), f32) * RET_V ** -0.5,
        'w_att_branch': nrm(ks[9], (DEPTH, ATT_OUT, D_MODEL), f32) * ATT_OUT ** -0.5,
        'w_out': nrm(ks[10], (DEPTH, D_MODEL, D_MODEL), f32) * D_MODEL ** -0.5,
        'norm_ffn': 1.0 + 0.01 * nrm(ks[11], (DEPTH, D_MODEL), f32),
        'w_gate_up': nrm(ks[12], (DEPTH, D_MODEL, 2 * D_FF), f32) * D_MODEL ** -0.5,
        'w_down': nrm(ks[13], (DEPTH, D_FF, D_MODEL), f32) * D_FF ** -0.5,
        'norm_final': 1.0 + 0.01 * nrm(ks[14], (D_MODEL,), f32),
    }


def reference(x_prompt, x_sample, state_ret, cache_kv_w128, cache_kv_w512, cache_kv_w2048,
              norm_mix, w_in, w_ret_branch, w_att_branch, w_out, norm_ffn, w_gate_up, w_down,
              norm_final):
    y_prompt, p_ret, p_kv = _trunk(x_prompt, None, None, norm_mix, w_in, w_ret_branch,
                                   w_att_branch, w_out, norm_ffn, w_gate_up, w_down, norm_final)
    y_sample, s_ret, s_kv = _trunk(x_sample, state_ret, (cache_kv_w128, cache_kv_w512, cache_kv_w2048),
                                   norm_mix, w_in, w_ret_branch, w_att_branch, w_out, norm_ffn,
                                   w_gate_up, w_down, norm_final)
    return (y_prompt, y_sample, p_ret, p_kv[0], p_kv[1], p_kv[2], s_ret, s_kv[0], s_kv[1], s_kv[2])
```

```cpp
#include <hip/hip_runtime.h>
#include <cstdio>
#include <cstdint>

typedef unsigned short bf16;
typedef float f32x4 __attribute__((ext_vector_type(4)));
typedef unsigned u32x4 __attribute__((ext_vector_type(4)));

constexpr int DM = 1024, NB = 2, T = 8192, DEPTH = 2, NS = 128, PAST = 2048;
constexpr int MPR = NB * T;
constexpr int MR = MPR + NS;
constexpr int MP = 16640;
constexpr int RH = 4, RDK = 128, RDV = 256, RCH = 128, NCH = T / RCH;
constexpr int RQK = 512, RV_ = 1024;
constexpr int AH = 4, HD = 64, AG = 3, AW = 768, AOUT = 256;
constexpr int DFF = 2816, DIN = 7424;
constexpr int C_RQ = 0, C_RK = 512, C_RV = 1024, C_RG = 2048, C_AQ = 3072, C_AK = 3840, C_AV = 4608, C_GR = 5376, C_GA = 6400;
constexpr float RMS_EPS = 1e-6f, GN_EPS = 1e-5f;

constexpr size_t O_YP = 0;
constexpr size_t O_YS = O_YP + (size_t)NB * T * DM;
constexpr size_t O_PRET = O_YS + (size_t)NS * DM;
constexpr size_t O_PKV0 = O_PRET + (size_t)DEPTH * NB * RH * RDK * RDV;
constexpr size_t O_PKV1 = O_PKV0 + (size_t)DEPTH * NB * 128 * 512;
constexpr size_t O_PKV2 = O_PKV1 + (size_t)DEPTH * NB * 512 * 512;
constexpr size_t O_SRET = O_PKV2 + (size_t)DEPTH * NB * 2048 * 512;
constexpr size_t O_SKV0 = O_SRET + (size_t)DEPTH * NS * RH * RDK * RDV;
constexpr size_t O_SKV1 = O_SKV0 + (size_t)DEPTH * NS * 512;
constexpr size_t O_SKV2 = O_SKV1 + (size_t)DEPTH * NS * 512;
constexpr size_t O_END = O_SKV2 + (size_t)DEPTH * NS * 512;
static_assert(O_END == 56885248, "output size");

constexpr size_t MiB = 1u << 20;
constexpr size_t al(size_t x) { return (x + MiB - 1) / MiB * MiB; }
constexpr size_t WS_XF = 1 * MiB;
constexpr size_t WS_HN = WS_XF + al((size_t)MP * DM * 4);
constexpr size_t WS_RQ = WS_HN + al((size_t)MP * DM * 2);
constexpr size_t WS_RK = WS_RQ + al((size_t)MP * 512 * 2);
constexpr size_t WS_RV = WS_RK + al((size_t)MP * 512 * 2);
constexpr size_t WS_RG = WS_RV + al((size_t)MP * 1024 * 2);
constexpr size_t WS_AQ = WS_RG + al((size_t)MP * 1024 * 2);
constexpr size_t WS_AK = WS_AQ + al((size_t)MP * 768 * 2);
constexpr size_t WS_AV = WS_AK + al((size_t)MP * 768 * 2);
constexpr size_t WS_GR = WS_AV + al((size_t)MP * 768 * 2);
constexpr size_t WS_GA = WS_GR + al((size_t)MP * 1024 * 2);
constexpr size_t WS_KVC = WS_GA + al((size_t)MP * 1024 * 2);
constexpr size_t WS_SC = WS_KVC + al((size_t)512 * 32768 * 4);
constexpr size_t WS_RO = WS_SC + al((size_t)512 * 32768 * 4);
constexpr size_t WS_AO = WS_RO + al((size_t)MP * 1024 * 2);
constexpr size_t WS_ABR = WS_AO + al((size_t)MP * 256 * 2);
constexpr size_t WS_MG = WS_ABR + al((size_t)MP * 1024 * 4);
constexpr size_t WS_H = WS_MG + al((size_t)MP * 1024 * 2);
constexpr size_t WS_C = WS_H + al((size_t)MP * DFF * 2);
constexpr size_t WS_END = WS_C + al((size_t)MP * DIN * 4);

__device__ __forceinline__ unsigned f2bf(float f) { unsigned u = __builtin_bit_cast(unsigned, f); return (u + 0x7fffu + ((u >> 16) & 1u)) >> 16; }
__device__ __forceinline__ float bf2f(bf16 b) { return __builtin_bit_cast(float, ((unsigned)b) << 16); }
__device__ __forceinline__ float sigmoidf_(float x) { return 1.f / (1.f + __expf(-x)); }
__device__ __forceinline__ float siluf_(float x) { return x / (1.f + __expf(-x)); }
__device__ __forceinline__ float wave_sum(float v) {
#pragma unroll
    for (int o = 1; o < 64; o <<= 1) v += __shfl_xor(v, o);
    return v;
}

__global__ void k_init_x(const float* xp, const float* xs, float* XF) {
    const size_t n = (size_t)MP * DM / 4;
    for (size_t i = (size_t)blockIdx.x * blockDim.x + threadIdx.x; i < n; i += (size_t)gridDim.x * blockDim.x) {
        const size_t e = i * 4; const int m = (int)(e / DM);
        f32x4 v = (f32x4){0.f, 0.f, 0.f, 0.f};
        if (m < MPR) v = *(const f32x4*)(xp + e);
        else if (m < MR) v = *(const f32x4*)(xs + (e - (size_t)MPR * DM));
        *(f32x4*)(XF + e) = v;
    }
}
__global__ void k_rmsnorm(const float* XF, const float* g, bf16* HN) {
    const int lane = threadIdx.x & 63, gw = (blockIdx.x * blockDim.x + threadIdx.x) >> 6, ngw = (gridDim.x * blockDim.x) >> 6;
    for (int m = gw; m < MP; m += ngw) {
        const f32x4* xr = (const f32x4*)(XF + (size_t)m * DM) + lane;
        f32x4 v[4]; float s = 0.f;
#pragma unroll
        for (int j = 0; j < 4; ++j) { v[j] = xr[64 * j]; s += (v[j].x * v[j].x + v[j].y * v[j].y) + (v[j].z * v[j].z + v[j].w * v[j].w); }
        const float rs = 1.f / sqrtf(wave_sum(s) * (1.f / DM) + RMS_EPS);
        unsigned long long* o8 = (unsigned long long*)(HN + (size_t)m * DM) + lane;
#pragma unroll
        for (int j = 0; j < 4; ++j) { const f32x4 gg = ((const f32x4*)g)[lane + 64 * j];
            const unsigned lo = f2bf(v[j].x * rs * gg.x) | (f2bf(v[j].y * rs * gg.y) << 16), hi = f2bf(v[j].z * rs * gg.z) | (f2bf(v[j].w * rs * gg.w) << 16);
            o8[64 * j] = (unsigned long long)lo | ((unsigned long long)hi << 32); }
    }
}
__global__ void k_final_norm(const float* XF, const float* g, float* out) {
    const int lane = threadIdx.x & 63, gw = (blockIdx.x * blockDim.x + threadIdx.x) >> 6, ngw = (gridDim.x * blockDim.x) >> 6;
    for (int m = gw; m < MR; m += ngw) {
        const f32x4* xr = (const f32x4*)(XF + (size_t)m * DM) + lane;
        f32x4 v[4]; float s = 0.f;
#pragma unroll
        for (int j = 0; j < 4; ++j) { v[j] = xr[64 * j]; s += (v[j].x * v[j].x + v[j].y * v[j].y) + (v[j].z * v[j].z + v[j].w * v[j].w); }
        const float rs = 1.f / sqrtf(wave_sum(s) * (1.f / DM) + RMS_EPS);
        float* orow = (m < MPR) ? out + O_YP + (size_t)m * DM : out + O_YS + (size_t)(m - MPR) * DM;
#pragma unroll
        for (int j = 0; j < 4; ++j) { const f32x4 gg = ((const f32x4*)g)[lane + 64 * j]; ((f32x4*)orow)[lane + 64 * j] = v[j] * rs * gg; }
    }
}
__global__ void __launch_bounds__(256) k_gemm_naive(const bf16* A, const float* W, float* C, int N, int K) {
    __shared__ float As[16][128 + 4];
    __shared__ float Bs[16][128 + 4];
    const int tid = threadIdx.x, tx = tid & 15, ty = tid >> 4;
    const int m0 = blockIdx.y * 128, n0 = blockIdx.x * 128;
    float acc[8][8];
#pragma unroll
    for (int i = 0; i < 8; ++i)
#pragma unroll
        for (int j = 0; j < 8; ++j) acc[i][j] = 0.f;
    for (int k0 = 0; k0 < K; k0 += 16) {
        { const int r = tid >> 1, kk = (tid & 1) * 8; const u32x4 q = *(const u32x4*)(A + (size_t)(m0 + r) * K + k0 + kk);
          const unsigned w[4] = {q.x, q.y, q.z, q.w};
#pragma unroll
          for (int j = 0; j < 4; ++j) { As[kk + 2 * j][r] = __builtin_bit_cast(float, w[j] << 16); As[kk + 2 * j + 1][r] = __builtin_bit_cast(float, w[j] & 0xffff0000u); } }
        { const int kk = tid >> 4, c = (tid & 15) * 8; const f32x4 a = *(const f32x4*)(W + (size_t)(k0 + kk) * N + n0 + c), b = *(const f32x4*)(W + (size_t)(k0 + kk) * N + n0 + c + 4);
          *(f32x4*)&Bs[kk][c] = a; *(f32x4*)&Bs[kk][c + 4] = b; }
        __syncthreads();
#pragma unroll
        for (int kk = 0; kk < 16; ++kk) {
            float a[8], b[8];
#pragma unroll
            for (int i = 0; i < 8; ++i) a[i] = As[kk][ty * 8 + i];
#pragma unroll
            for (int j = 0; j < 8; ++j) b[j] = Bs[kk][tx * 8 + j];
#pragma unroll
            for (int i = 0; i < 8; ++i)
#pragma unroll
                for (int j = 0; j < 8; ++j) acc[i][j] += a[i] * b[j];
        }
        __syncthreads();
    }
#pragma unroll
    for (int i = 0; i < 8; ++i) { float* cr = C + (size_t)(m0 + ty * 8 + i) * N + n0 + tx * 8;
        *(f32x4*)cr = (f32x4){acc[i][0], acc[i][1], acc[i][2], acc[i][3]}; *(f32x4*)(cr + 4) = (f32x4){acc[i][4], acc[i][5], acc[i][6], acc[i][7]}; }
}
struct Bufs { bf16 *RQ, *RK, *RV, *RG, *AQ, *AK, *AV, *GR, *GA; };
__global__ void k_proj_epi(const float* C, Bufs B, float* out, int layer) {
    const size_t n = (size_t)MP * DIN;
    for (size_t i = (size_t)blockIdx.x * blockDim.x + threadIdx.x; i < n; i += (size_t)gridDim.x * blockDim.x) {
        const int m = (int)(i / DIN), c = (int)(i % DIN); const float v = C[i];
        if (c < C_RK) B.RQ[(size_t)m * 512 + c] = (bf16)f2bf(v * 0.08838834764831845f);
        else if (c < C_RV) B.RK[(size_t)m * 512 + (c - C_RK)] = (bf16)f2bf(v);
        else if (c < C_RG) B.RV[(size_t)m * 1024 + (c - C_RV)] = (bf16)f2bf(v);
        else if (c < C_AQ) B.RG[(size_t)m * 1024 + (c - C_RG)] = (bf16)f2bf(siluf_(v));
        else if (c < C_AK) B.AQ[(size_t)m * 768 + (c - C_AQ)] = (bf16)f2bf(v * 0.125f);
        else if (c < C_GR) {
            const int kv = (c >= C_AV) ? 1 : 0, cc = c - (kv ? C_AV : C_AK), g = cc >> 8, hd = cc & 255;
            (kv ? B.AV : B.AK)[(size_t)m * 768 + cc] = (bf16)f2bf(v);
            const int keep = (g == 0) ? 128 : (g == 1 ? 512 : 2048);
            if (m < MPR) { const int b = m / T, t = m % T;
                if (t >= T - keep) { float* o = out + (g == 0 ? O_PKV0 : (g == 1 ? O_PKV1 : O_PKV2));
                    o[((((size_t)layer * NB + b) * keep + (t - (T - keep))) * 2 + kv) * 256 + hd] = v; } }
            else if (m < MR) { const int nn = m - MPR; float* o = out + (g == 0 ? O_SKV0 : (g == 1 ? O_SKV1 : O_SKV2));
                o[(((size_t)layer * NS + nn) * 2 + kv) * 256 + hd] = v; }
        }
        else if (c < C_GA) B.GR[(size_t)m * 1024 + (c - C_GR)] = (bf16)f2bf(sigmoidf_(v));
        else B.GA[(size_t)m * 1024 + (c - C_GA)] = (bf16)f2bf(sigmoidf_(v));
    }
}
__device__ __forceinline__ float log_gamma_h(int h) { return log1pf(-exp2f(-5.0f - (float)h)); }
__global__ void __launch_bounds__(256) k_ret_kv(const bf16* RK, const bf16* RV, float* KVC) {
    const int u = blockIdx.x, c = u & 63, h = (u >> 6) & 3, b = u >> 8;
    const float lg = log_gamma_h(h);
    const size_t row0 = (size_t)b * T + (size_t)c * RCH;
    const int v = threadIdx.x;
    for (int d0 = 0; d0 < 128; d0 += 16) {
        float acc[16];
#pragma unroll
        for (int d = 0; d < 16; ++d) acc[d] = 0.f;
        for (int j = 0; j < 128; ++j) { const float x = bf2f(RV[(row0 + j) * 1024 + h * 256 + v]) * __expf((127.f - (float)j) * lg);
            const bf16* kr = RK + (row0 + j) * 512 + h * 128 + d0;
#pragma unroll
            for (int d = 0; d < 16; ++d) acc[d] += bf2f(kr[d]) * x; }
#pragma unroll
        for (int d = 0; d < 16; ++d) KVC[(size_t)u * 32768 + (size_t)(d0 + d) * 256 + v] = acc[d];
    }
}
__global__ void k_ret_scan(const float* KVC, float* SC, float* out, int layer) {
    const int i = blockIdx.x * blockDim.x + threadIdx.x;
    if (i >= 8 * 32768) return;
    const int bh = i >> 15, e = i & 32767, h = bh & 3;
    const float g128 = __expf(128.f * log_gamma_h(h));
    float S = 0.f;
    for (int c = 0; c < NCH; ++c) { const size_t o = ((size_t)bh * 64 + c) * 32768 + e; SC[o] = S; S = S * g128 + KVC[o]; }
    out[O_PRET + ((size_t)layer * 8 + bh) * 32768 + e] = S;
}
__global__ void __launch_bounds__(512) k_ret_out(const bf16* RQ, const bf16* RK, const bf16* RV, const float* SC, const bf16* RG, bf16* RO) {
    const int u = blockIdx.x, c = u & 63, h = (u >> 6) & 3, b = u >> 8;
    extern __shared__ float sc[];
    const float lg = log_gamma_h(h);
    const size_t row0 = (size_t)b * T + (size_t)c * RCH;
    const int tid = threadIdx.x, i = tid >> 2, vq = tid & 3;
    for (int j = vq; j < 128; j += 4) {
        float s = 0.f;
        if (j <= i) { for (int d = 0; d < 128; ++d) s += bf2f(RQ[(row0 + i) * 512 + h * 128 + d]) * bf2f(RK[(row0 + j) * 512 + h * 128 + d]); s *= __expf((float)(i - j) * lg); }
        sc[i * 129 + j] = s;
    }
    __syncthreads();
    float o[64];
#pragma unroll
    for (int x = 0; x < 64; ++x) o[x] = 0.f;
    for (int j = 0; j <= i; ++j) { const float s = sc[i * 129 + j]; const bf16* vr = RV + (row0 + j) * 1024 + h * 256 + vq * 64;
#pragma unroll
        for (int x = 0; x < 64; ++x) o[x] += s * bf2f(vr[x]); }
    const float inner = __expf((float)(i + 1) * lg);
    const float* S = SC + (size_t)u * 32768 + vq * 64;
    for (int d = 0; d < 128; ++d) { const float qd = bf2f(RQ[(row0 + i) * 512 + h * 128 + d]) * inner;
#pragma unroll
        for (int x = 0; x < 64; ++x) o[x] += qd * S[(size_t)d * 256 + x]; }
    float s1 = 0.f;
#pragma unroll
    for (int x = 0; x < 64; ++x) s1 += o[x];
    s1 += __shfl_xor(s1, 1); s1 += __shfl_xor(s1, 2);
    const float mu = s1 * (1.f / 256.f); float s2 = 0.f;
#pragma unroll
    for (int x = 0; x < 64; ++x) { const float dd = o[x] - mu; s2 += dd * dd; }
    s2 += __shfl_xor(s2, 1); s2 += __shfl_xor(s2, 2);
    const float rstd = 1.f / sqrtf(s2 * (1.f / 256.f) + GN_EPS);
    const size_t ob = (row0 + i) * 1024 + h * 256 + vq * 64;
#pragma unroll
    for (int x = 0; x < 64; ++x) RO[ob + x] = (bf16)f2bf((o[x] - mu) * rstd * bf2f(RG[ob + x]));
}
__global__ void __launch_bounds__(256) k_ret_sample(const bf16* RQ, const bf16* RK, const bf16* RV, const bf16* RG, const float* state, bf16* RO, float* out, int layer) {
    const int n = blockIdx.x >> 2, h = blockIdx.x & 3, v = threadIdx.x;
    const size_t m = (size_t)MPR + n;
    const float gam = 1.f - exp2f(-5.f - (float)h);
    const float* s0 = state + (((size_t)layer * NS + n) * RH + h) * 32768;
    float* s1o = out + O_SRET + (((size_t)layer * NS + n) * RH + h) * 32768;
    const float vv = bf2f(RV[m * 1024 + h * 256 + v]);
    float o = 0.f;
    for (int d = 0; d < 128; ++d) { const float s1 = gam * s0[(size_t)d * 256 + v] + bf2f(RK[m * 512 + h * 128 + d]) * vv; s1o[(size_t)d * 256 + v] = s1; o += bf2f(RQ[m * 512 + h * 128 + d]) * s1; }
    __shared__ float red[8];
    float s = wave_sum(o); if ((v & 63) == 0) red[v >> 6] = s; __syncthreads();
    const float mu = (red[0] + red[1] + red[2] + red[3]) * (1.f / 256.f);
    const float dd = o - mu; float q = wave_sum(dd * dd); if ((v & 63) == 0) red[4 + (v >> 6)] = q; __syncthreads();
    const float rstd = 1.f / sqrtf((red[4] + red[5] + red[6] + red[7]) * (1.f / 256.f) + GN_EPS);
    RO[m * 1024 + h * 256 + v] = (bf16)f2bf(dd * rstd * bf2f(RG[m * 1024 + h * 256 + v]));
}
__device__ __forceinline__ float dot64_bf(const float (&q)[64], const bf16* p) { float s = 0.f;
#pragma unroll
    for (int d = 0; d < 64; ++d) s += q[d] * bf2f(p[d]);
    return s; }
__device__ __forceinline__ float dot64_f(const float (&q)[64], const float* p) { float s = 0.f;
#pragma unroll
    for (int d = 0; d < 64; ++d) s += q[d] * p[d];
    return s; }
__global__ void __launch_bounds__(256) k_attn(const bf16* AQ, const bf16* AK, const bf16* AV, const float* c0, const float* c1, const float* c2, bf16* AO, int layer) {
    const int idx = blockIdx.x * blockDim.x + threadIdx.x;
    if (idx >= MR * AH) return;
    const int m = idx >> 2, h = idx & 3;
    float mx = -INFINITY, l = 0.f, o[64];
#pragma unroll
    for (int d = 0; d < 64; ++d) o[d] = 0.f;
    for (int g = 0; g < 3; ++g) {
        const int dil = (g == 0) ? 1 : (g == 1 ? 4 : 16), win = 128 * dil;
        const float slope = exp2f(-8.f * (float)(g * 4 + h + 1) / 12.f);
        float q[64];
#pragma unroll
        for (int d = 0; d < 64; ++d) q[d] = bf2f(AQ[(size_t)m * 768 + g * 256 + h * 64 + d]);
        for (int j = 0; j <= 128; ++j) {
            float s; const bf16* vb = nullptr; const float* vf = nullptr;
            if (m < MPR) { const int t = m % T, kt = t - dil * j; if (kt < 0) break; const size_t r = (size_t)(m - dil * j);
                s = dot64_bf(q, AK + r * 768 + g * 256 + h * 64); vb = AV + r * 768 + g * 256 + h * 64; }
            else if (j == 0) { s = dot64_bf(q, AK + (size_t)m * 768 + g * 256 + h * 64); vb = AV + (size_t)m * 768 + g * 256 + h * 64; }
            else { const int n = m - MPR, wlen = (win < PAST) ? win : PAST, r = wlen - dil * j; const float* cb = (g == 0) ? c0 : (g == 1 ? c1 : c2);
                const float* p = cb + ((((size_t)layer * NS + n) * wlen + r) * 2) * 256 + h * 64;
                s = dot64_f(q, p); vf = p + 256; }
            s -= slope * (float)(dil * j);
            const float mn = fmaxf(mx, s), corr = __expf(mx - mn), p = __expf(s - mn);
            l = l * corr + p; mx = mn;
            if (vb) {
#pragma unroll
                for (int d = 0; d < 64; ++d) o[d] = o[d] * corr + p * bf2f(vb[d]); }
            else {
#pragma unroll
                for (int d = 0; d < 64; ++d) o[d] = o[d] * corr + p * vf[d]; }
        }
    }
    const float inv = 1.f / l;
#pragma unroll
    for (int d = 0; d < 64; ++d) AO[(size_t)m * 256 + h * 64 + d] = (bf16)f2bf(o[d] * inv);
}
__global__ void k_abr_epi(const float* C, const bf16* GA, float* ABR) {
    const size_t n = (size_t)MP * DM;
    for (size_t i = (size_t)blockIdx.x * blockDim.x + threadIdx.x; i < n; i += (size_t)gridDim.x * blockDim.x) ABR[i] = bf2f(GA[i]) * C[i];
}
__global__ void k_rbr_epi(const float* C, const bf16* GR, const float* ABR, bf16* MG) {
    const size_t n = (size_t)MP * DM;
    for (size_t i = (size_t)blockIdx.x * blockDim.x + threadIdx.x; i < n; i += (size_t)gridDim.x * blockDim.x) MG[i] = (bf16)f2bf(bf2f(GR[i]) * C[i] + ABR[i]);
}
__global__ void k_resid_epi(const float* C, float* XF) {
    const size_t n = (size_t)MP * DM;
    for (size_t i = (size_t)blockIdx.x * blockDim.x + threadIdx.x; i < n; i += (size_t)gridDim.x * blockDim.x) XF[i] += C[i];
}
__global__ void k_swiglu_epi(const float* C, bf16* H) {
    const size_t n = (size_t)MP * DFF;
    for (size_t i = (size_t)blockIdx.x * blockDim.x + threadIdx.x; i < n; i += (size_t)gridDim.x * blockDim.x) { const size_t m = i / DFF, j = i % DFF;
        H[i] = (bf16)f2bf(siluf_(C[m * (2 * DFF) + j]) * C[m * (2 * DFF) + DFF + j]); }
}
__global__ void k_zero_pad_rows(bf16* p, int cols) {
    const size_t n = (size_t)(MP - MR) * cols;
    for (size_t i = (size_t)blockIdx.x * blockDim.x + threadIdx.x; i < n; i += (size_t)gridDim.x * blockDim.x) p[(size_t)MR * cols + i] = 0;
}

extern "C" void kernel_launch(void* const* d_in, const int* in_sizes, int n_in, void* d_out, int out_size, void* d_ws, size_t ws_size, hipStream_t stream) {
    if (n_in != 15 || out_size != (int)O_END || ws_size < WS_END) { fprintf(stderr, "kernel_launch: unexpected shapes n_in %d out %d ws %zu (need %zu)\n", n_in, out_size, ws_size, (size_t)WS_END); return; }
    const float* xp = (const float*)d_in[0]; const float* xs = (const float*)d_in[1]; const float* state = (const float*)d_in[2];
    const float* c0 = (const float*)d_in[3]; const float* c1 = (const float*)d_in[4]; const float* c2 = (const float*)d_in[5];
    const float* norm_mix = (const float*)d_in[6]; const float* w_in = (const float*)d_in[7]; const float* w_ret = (const float*)d_in[8]; const float* w_att = (const float*)d_in[9];
    const float* w_out = (const float*)d_in[10]; const float* norm_ffn = (const float*)d_in[11]; const float* w_gu = (const float*)d_in[12]; const float* w_down = (const float*)d_in[13]; const float* norm_final = (const float*)d_in[14];
    float* out = (float*)d_out; unsigned char* ws = (unsigned char*)d_ws;
    float* XF = (float*)(ws + WS_XF); bf16* HN = (bf16*)(ws + WS_HN);
    Bufs B{(bf16*)(ws + WS_RQ), (bf16*)(ws + WS_RK), (bf16*)(ws + WS_RV), (bf16*)(ws + WS_RG), (bf16*)(ws + WS_AQ), (bf16*)(ws + WS_AK), (bf16*)(ws + WS_AV), (bf16*)(ws + WS_GR), (bf16*)(ws + WS_GA)};
    float* KVC = (float*)(ws + WS_KVC); float* SC = (float*)(ws + WS_SC); bf16* RO = (bf16*)(ws + WS_RO); bf16* AO = (bf16*)(ws + WS_AO);
    float* ABR = (float*)(ws + WS_ABR); bf16* MG = (bf16*)(ws + WS_MG); bf16* H = (bf16*)(ws + WS_H); float* C = (float*)(ws + WS_C);
    static bool attr_done = false;
    if (!attr_done) { (void)hipFuncSetAttribute((const void*)k_ret_out, hipFuncAttributeMaxDynamicSharedMemorySize, 128 * 129 * 4); attr_done = true; }

    k_init_x<<<2048, 256, 0, stream>>>(xp, xs, XF);
    k_zero_pad_rows<<<64, 256, 0, stream>>>(RO, 1024);
    k_zero_pad_rows<<<64, 256, 0, stream>>>(AO, 256);
    for (int l = 0; l < DEPTH; ++l) {
        k_rmsnorm<<<2048, 256, 0, stream>>>(XF, norm_mix + (size_t)l * DM, HN);
        k_gemm_naive<<<dim3(DIN / 128, MP / 128), 256, 0, stream>>>(HN, w_in + (size_t)l * DM * DIN, C, DIN, DM);
        k_proj_epi<<<4096, 256, 0, stream>>>(C, B, out, l);
        k_ret_kv<<<512, 256, 0, stream>>>(B.RK, B.RV, KVC);
        k_ret_scan<<<8 * 32768 / 256, 256, 0, stream>>>(KVC, SC, out, l);
        k_ret_out<<<512, 512, 128 * 129 * 4, stream>>>(B.RQ, B.RK, B.RV, SC, B.RG, RO);
        k_ret_sample<<<NS * RH, 256, 0, stream>>>(B.RQ, B.RK, B.RV, B.RG, state, RO, out, l);
        k_attn<<<(MR * AH + 255) / 256, 256, 0, stream>>>(B.AQ, B.AK, B.AV, c0, c1, c2, AO, l);
        k_gemm_naive<<<dim3(DM / 128, MP / 128), 256, 0, stream>>>(AO, w_att + (size_t)l * AOUT * DM, C, DM, AOUT);
        k_abr_epi<<<4096, 256, 0, stream>>>(C, B.GA, ABR);
        k_gemm_naive<<<dim3(DM / 128, MP / 128), 256, 0, stream>>>(RO, w_ret + (size_t)l * RV_ * DM, C, DM, RV_);
        k_rbr_epi<<<4096, 256, 0, stream>>>(C, B.GR, ABR, MG);
        k_gemm_naive<<<dim3(DM / 128, MP / 128), 256, 0, stream>>>(MG, w_out + (size_t)l * DM * DM, C, DM, DM);
        k_resid_epi<<<4096, 256, 0, stream>>>(C, XF);
        k_rmsnorm<<<2048, 256, 0, stream>>>(XF, norm_ffn + (size_t)l * DM, HN);
        k_gemm_naive<<<dim3(2 * DFF / 128, MP / 128), 256, 0, stream>>>(HN, w_gu + (size_t)l * DM * 2 * DFF, C, 2 * DFF, DM);
        k_swiglu_epi<<<4096, 256, 0, stream>>>(C, H);
        k_gemm_naive<<<dim3(DM / 128, MP / 128), 256, 0, stream>>>(H, w_down + (size_t)l * DFF * DM, C, DM, DFF);
        k_resid_epi<<<4096, 256, 0, stream>>>(C, XF);
    }
    k_final_norm<<<2048, 256, 0, stream>>>(XF, norm_final, out);
}
```

```cpp
#include <hip/hip_runtime.h>
#include <cstdio>
#include <cstdint>
__device__ __forceinline__ int lane_id() { int l; asm volatile("v_mbcnt_lo_u32_b32 %0, -1, 0\n\tv_mbcnt_hi_u32_b32 %0, -1, %0" : "=&v"(l)); return l; }
constexpr int DM = 1024, NB = 2, T = 8192, DEPTH = 2, NS = 128, PAST = 2048;
constexpr int MPR = NB * T;
constexpr int MR = MPR + NS;
constexpr int MP = 16640;
constexpr int RH = 4, RCH = 128, NCH = T / RCH;
constexpr int AH = 4;
constexpr int DFF = 2816, DIN = 7424;
constexpr float RMS_EPS = 1e-6f, GN_EPS = 1e-5f;
constexpr size_t O_YP = 0;
constexpr size_t O_YS = O_YP + (size_t)NB * T * DM;
constexpr size_t O_PRET = O_YS + (size_t)NS * DM;
constexpr size_t O_PKV0 = O_PRET + (size_t)DEPTH * NB * RH * 128 * 256;
constexpr size_t O_PKV1 = O_PKV0 + (size_t)DEPTH * NB * 128 * 512;
constexpr size_t O_PKV2 = O_PKV1 + (size_t)DEPTH * NB * 512 * 512;
constexpr size_t O_SRET = O_PKV2 + (size_t)DEPTH * NB * 2048 * 512;
constexpr size_t O_SKV0 = O_SRET + (size_t)DEPTH * NS * RH * 128 * 256;
constexpr size_t O_SKV1 = O_SKV0 + (size_t)DEPTH * NS * 512;
constexpr size_t O_SKV2 = O_SKV1 + (size_t)DEPTH * NS * 512;
constexpr size_t O_END = O_SKV2 + (size_t)DEPTH * NS * 512;
static_assert(O_END == 56885248, "output size");
constexpr size_t MiB = 1u << 20;
constexpr size_t al(size_t x) { return (x + MiB - 1) / MiB * MiB; }
constexpr size_t WS_CTL = 0, CTL_ZERO_BYTES = 32768;
constexpr size_t WS_XF = 1 * MiB;
constexpr size_t WS_HN = WS_XF + al((size_t)MP * DM * 4);
constexpr size_t WS_RQ = WS_HN + al((size_t)MP * DM * 2);
constexpr size_t WS_RK = WS_RQ + al((size_t)MP * 512 * 2);
constexpr size_t WS_RV = WS_RK + al((size_t)MP * 512 * 2);
constexpr size_t WS_RG = WS_RV + al((size_t)MP * 1024 * 2);
constexpr size_t WS_AQ = WS_RG + al((size_t)MP * 1024 * 2);
constexpr size_t WS_AK = WS_AQ + al((size_t)MP * 768 * 2);
constexpr size_t WS_AV = WS_AK + al((size_t)MP * 768 * 2);
constexpr size_t WS_GR = WS_AV + al((size_t)MP * 768 * 2);
constexpr size_t WS_GA = WS_GR + al((size_t)MP * 1024 * 2);
constexpr size_t WS_KVC = WS_GA + al((size_t)MP * 1024 * 2);
constexpr size_t WS_SC = WS_KVC + al((size_t)512 * 32768 * 4);
constexpr size_t WS_RO = WS_SC + al((size_t)512 * 32768 * 4);
constexpr size_t WS_AO = WS_RO + al((size_t)MP * 1024 * 2);
constexpr size_t WS_ABR = WS_AO + al((size_t)MP * 256 * 2);
constexpr size_t WS_MG = WS_ABR + al((size_t)MP * 1024 * 4);
constexpr size_t WS_H = WS_MG + al((size_t)MP * 1024 * 2);
constexpr size_t WS_OG = WS_H + al((size_t)MP * DFF * 2);
constexpr size_t WS_LSE = WS_OG + al((size_t)3 * MP * 256 * 2);
constexpr size_t WS_XB = WS_LSE + al((size_t)3 * MP * 4 * 4);
constexpr size_t WS_SSP = WS_XB + al((size_t)MP * DM * 2);
constexpr size_t WS_SSS = WS_SSP + al((size_t)5 * MPR * 16 * 4);
constexpr size_t WS_W = WS_SSS + al((size_t)5 * NS * 4);
constexpr size_t W_IN = 0, W_RET = W_IN + (size_t)DIN * DM * 2, W_ATT = W_RET + (size_t)DM * DM * 2, W_OUT = W_ATT + (size_t)DM * 256 * 2,
                 W_GU = W_OUT + (size_t)DM * DM * 2, W_DN = W_GU + (size_t)2 * DFF * DM * 2, W_LAYER = al(W_DN + (size_t)DM * DFF * 2);
constexpr size_t WS_END = WS_W + DEPTH * W_LAYER;
constexpr int CW_TMO = 0, CW_PAN = 1024  , CW_BAR = 4096;
constexpr int RING_BYTES = 131072, LDSCTL_OFF = RING_BYTES, MISC_OFF = LDSCTL_OFF + 320, LDS_BYTES = 147456;
constexpr int NWAVES = 8, NTHR = 512;
namespace pg8 {
#define PG8_LAS __attribute__((address_space(3)))
typedef unsigned short bf16_t;
typedef short bf16x8 __attribute__((ext_vector_type(8)));
typedef float f32x4 __attribute__((ext_vector_type(4)));
typedef unsigned u32x4 __attribute__((ext_vector_type(4)));
constexpr int BM = 256, BK = 64, HALF = 128, HTB = HALF * BK * 2  , STAGE_BYTES = 8 * HTB, NXCD = 8, WGM = 4;

__host__ __device__ __forceinline__ int lds_byte(int r, int c) { const int st = (r >> 4) * 2 + (c >> 5), rr = r & 15, cc = c & 31, ob = rr * 64 + cc * 2; return st * 1024 + (ob ^ (((ob >> 9) & 1) << 5)); }
__host__ __device__ __forceinline__ void stage_rc(int b, int& R, int& C) { const int st = b / 1024, sb = b % 1024, swz = sb ^ (((sb >> 9) & 1) << 5); R = (st >> 1) * 16 + swz / 64; C = (st & 1) * 32 + (swz % 64) / 2; }
__host__ __device__ __forceinline__ int perm32(int rho) { const int n = rho >> 4, i = rho & 15; return 8 * (i >> 2) + 4 * n + (i & 3); }

struct Unit { int pm, pn, half; };
struct Gemm { const bf16_t* A; const bf16_t* Bt; int M, N, K; };

struct StaticOrder {
    int nM, nN, nwg, G, c;
    __host__ __device__ void init(int M, int N, int G_, int c_, int split_ = 0, int tail_even_ = 0) { nM = M / BM; nN = N / BM; nwg = nM * nN; G = G_; c = c_; split = split_; tail_even = tail_even_; }
    __host__ __device__ __attribute__((always_inline)) int tail_pm() const { Unit u; return next(nwg / G, u) ? u.pm : -1; }
    int tail_even;
    int split;
    __host__ __device__ __attribute__((always_inline)) bool next(int i, Unit& u) const {
        const int nfull = nwg / G, rem = nwg % G; long L; u.half = -1;
        if (i < nfull) L = (long)i * G + c;
        else if (i == nfull && split && rem > 0 && 2 * rem <= G) { if (c >= 2 * rem) return false; L = (long)nfull * G + (c >> 1); u.half = c & 1; }
        else if (i == nfull && tail_even) { if ((c & 1) || (c >> 1) >= rem) return false; L = (long)nfull * G + (c >> 1); }
        else { L = (long)i * G + c; if (L >= nwg) return false; }
        int wgid = (int)L; { const int q = nwg / NXCD, r = nwg % NXCD, xcd = wgid % NXCD, off = wgid / NXCD; wgid = (xcd < r ? xcd * (q + 1) : r * (q + 1) + (xcd - r) * q) + off; }
        const int nig = WGM * nN, gid = wgid / nig, fm = gid * WGM, gsz = (nM - fm) < WGM ? (nM - fm) : WGM;
        u.pm = fm + ((wgid % nig) % gsz); u.pn = (wgid % nig) / gsz; return true;
    }
    __device__ __forceinline__ void a_ready(const Unit&) const {}
    __device__ __forceinline__ void done(const Unit&) const {}
};
struct ColTileOrder { int pm, pn; __host__ __device__ bool next(int i, Unit& u) const { if (i != 0) return false; u.pm = pm; u.pn = pn; u.half = -1; return true; }
    __device__ __forceinline__ void a_ready(const Unit&) const {} __device__ __forceinline__ void done(const Unit&) const {} };
typedef float f32x2_t __attribute__((ext_vector_type(2))); typedef __bf16 bf16x2_t __attribute__((ext_vector_type(2)));
__device__ __forceinline__ unsigned cvt_pk_bf16(float lo, float hi) { f32x2_t v = {lo, hi}; bf16x2_t b = __builtin_convertvector(v, bf16x2_t); return __builtin_bit_cast(unsigned, b); }
typedef float f32x2 __attribute__((ext_vector_type(2)));
typedef unsigned u32x2 __attribute__((ext_vector_type(2)));
__device__ __forceinline__ float bf_lo(unsigned w) { return __builtin_bit_cast(float, w << 16); }
__device__ __forceinline__ float bf_hi(unsigned w) { return __builtin_bit_cast(float, w & 0xffff0000u); }
__device__ __forceinline__ float fast_sigmoid(float x) { return __builtin_amdgcn_rcpf(1.f + __expf(-x)); }
constexpr int RS_LDS_OFF = 131072 + 1024, RS_LDS_ROWS = 2048;
__device__ __forceinline__ float rs_tab(int row_rel) { return ((const PG8_LAS float*)(size_t)RS_LDS_OFF)[row_rel]; }
__device__ __forceinline__ float row_rs(const float* ssp, int row) { return __builtin_amdgcn_rsqf(ssp[row] * (1.f / DM) + RMS_EPS); }
__device__ __forceinline__ float row_rs_s(const float* sss, int n) { return __builtin_amdgcn_rsqf(sss[n] * (1.f / DM) + RMS_EPS); }
struct EpiProj {
    static constexpr bool PERM = true, AFTER_DRAIN = false, ADJ = true;
    unsigned char* ws; float* out; int layer; const float* ssp; const float* sss; int rs_row0;
    static __device__ __forceinline__ unsigned xor8(unsigned x) { return (unsigned)__builtin_amdgcn_update_dpp(0, (int)x, 0x128, 0xf, 0xf, false); }
    template <int MODE>
    __device__ __forceinline__ void body(const f32x4 (&acc)[2][2][4][2], const Unit& u, int wr, int wc, int fr, int fq, bf16_t* base, int ldc, int colt, float sc, int g, int kvsel) const {
        const int rloc = wr * 64 + fr, cloc = wc * 64 + 8 * fq;
        const int nai = u.half < 0 ? 2 : 1, roff = u.half > 0 ? HALF : 0;
        const bool lo = fr < 8;
        const int tb = ((unsigned)(u.pm * BM - rs_row0) < (unsigned)RS_LDS_ROWS) ? u.pm * BM - rs_row0 : RS_LDS_ROWS;
        float rsv[2][4];
#pragma unroll
        for (int ai = 0; ai < 2; ++ai)
#pragma unroll
            for (int m = 0; m < 4; ++m) { const int row = u.pm * BM + roff + ai * HALF + m * 16 + rloc; rsv[ai][m] = (ai < nai) ? (rs_row0 >= 0 ? rs_tab(row - u.pm * BM + tb) : row_rs(ssp, row)) : 0.f; }
#pragma unroll
        for (int ai = 0; ai < 2; ++ai) if (ai < nai)
#pragma unroll
            for (int m = 0; m < 4; ++m) {
                const int rt = roff + ai * HALF + m * 16 + rloc;
                const float rs = rsv[ai][m];
                u32x4 w[2];
#pragma unroll
                for (int bj = 0; bj < 2; ++bj) {
                    f32x4 v0 = acc[ai][bj][m][0] * rs, v1 = acc[ai][bj][m][1] * rs;
                    if (MODE == 3) {
                        const int keep = 128 << (2 * g); const int hd = bj * 32 + cloc; float* dst = nullptr;
                        if (u.pm < 64) { const int b = u.pm >> 5, t = (u.pm & 31) * 256 + rt;
                            if (t >= T - keep) dst = out + (g == 0 ? O_PKV0 : (g == 1 ? O_PKV1 : O_PKV2)) + ((((size_t)layer * NB + b) * keep + (t - (T - keep))) * 2 + kvsel) * 256 + hd; }
                        else if (rt < NS) dst = out + (g == 0 ? O_SKV0 : (g == 1 ? O_SKV1 : O_SKV2)) + (((size_t)layer * NS + rt) * 2 + kvsel) * 256 + hd;
                        if (dst) { *(f32x4*)dst = v0; *(f32x4*)(dst + 4) = v1; }
                    } else if (MODE == 1) {
#pragma unroll
                        for (int j = 0; j < 4; ++j) { v0[j] = v0[j] * fast_sigmoid(v0[j]); v1[j] = v1[j] * fast_sigmoid(v1[j]); }
                    } else if (MODE == 2) {
#pragma unroll
                        for (int j = 0; j < 4; ++j) { v0[j] = fast_sigmoid(v0[j]); v1[j] = fast_sigmoid(v1[j]); }
                    } else if (MODE == 4) {
                        const int hh = g + (wc >> 1);
                        const float lg2 = (hh == 0) ? -0.045803689613124f : (hh == 1 ? -0.022720076500083f : (hh == 2 ? -0.011315313227834f : -0.005646563141142f));
                        const float ii = (u.pm < 64) ? (float)(m * 16 + rloc) : 0.f;
                        const float f = sc * __builtin_amdgcn_exp2f((kvsel ? -ii : ii) * lg2);
                        v0 = v0 * f; v1 = v1 * f;
                    } else { v0 = v0 * sc; v1 = v1 * sc; }
                    w[bj].x = cvt_pk_bf16(v0[0], v0[1]); w[bj].y = cvt_pk_bf16(v0[2], v0[3]); w[bj].z = cvt_pk_bf16(v1[0], v1[1]); w[bj].w = cvt_pk_bf16(v1[2], v1[3]);
                }
                u32x4 rcv;
#pragma unroll
                for (int j = 0; j < 4; ++j) rcv[j] = xor8(lo ? w[1][j] : w[0][j]);
                const u32x4 dA = lo ? w[0] : rcv, dB = lo ? rcv : w[1];
                bf16_t* rowA = base + (size_t)(u.pm * BM + roff + ai * HALF + m * 16 + wr * 64 + (fr & 7)) * ldc + colt + wc * 64 + 32 * (fr >> 3) + 8 * fq;
                __builtin_nontemporal_store(dA, (u32x4*)rowA);
                __builtin_nontemporal_store(dB, (u32x4*)(rowA + (size_t)8 * ldc));
            }
    }
    __device__ __forceinline__ void small(int n, int c, f32x4 v) const {
        const size_t row = (size_t)MPR + n; bf16_t* dst; float sc = 1.f; int mode = 0;
        v = v * row_rs_s(sss, n);
        if (c < 512) { dst = (bf16_t*)(ws + WS_RQ) + row * 512 + c; sc = 0.08838834764831845f; }
        else if (c < 1024) dst = (bf16_t*)(ws + WS_RK) + row * 512 + (c - 512);
        else if (c < 2048) dst = (bf16_t*)(ws + WS_RV) + row * 1024 + (c - 1024);
        else if (c < 3072) { dst = (bf16_t*)(ws + WS_RG) + row * 1024 + (c - 2048); mode = 1; }
        else if (c < 3840) { dst = (bf16_t*)(ws + WS_AQ) + row * 768 + (c - 3072); sc = 0.125f * 1.4426950408889634f; }
        else if (c < 5376) { const int kv = c >= 4608, cc = c - (kv ? 4608 : 3840), g = cc >> 8, hd = cc & 255;
            dst = (bf16_t*)(ws + (kv ? WS_AV : WS_AK)) + row * 768 + cc;
            *(f32x4*)(out + (g == 0 ? O_SKV0 : (g == 1 ? O_SKV1 : O_SKV2)) + (((size_t)layer * NS + n) * 2 + kv) * 256 + hd) = v; }
        else if (c < 6400) { dst = (bf16_t*)(ws + WS_GR) + row * 1024 + (c - 5376); mode = 2; }
        else { dst = (bf16_t*)(ws + WS_GA) + row * 1024 + (c - 6400); mode = 2; }
        if (mode == 1) {
#pragma unroll
            for (int j = 0; j < 4; ++j) v[j] = v[j] * fast_sigmoid(v[j]); }
        else if (mode == 2) {
#pragma unroll
            for (int j = 0; j < 4; ++j) v[j] = fast_sigmoid(v[j]); }
        else v = v * sc;
        u32x2 w; w.x = cvt_pk_bf16(v[0], v[1]); w.y = cvt_pk_bf16(v[2], v[3]); *(u32x2*)dst = w;
    }
    __device__ __forceinline__ void operator()(const f32x4 (&acc)[2][2][4][2], const Unit& u, int wr, int wc, int fr_, int fq_) const {
        int fr = fr_, fq = fq_; asm volatile("" : "+v"(fr), "+v"(fq));
        const int pn = u.pn;
        if (pn < 2) body<4>(acc, u, wr, wc, fr, fq, (bf16_t*)(ws + WS_RQ), 512, pn * 256, 0.08838834764831845f, 2 * pn, 0);
        else if (pn < 4) body<4>(acc, u, wr, wc, fr, fq, (bf16_t*)(ws + WS_RK), 512, (pn - 2) * 256, 1.f, 2 * (pn - 2), 1);
        else if (pn < 8) body<0>(acc, u, wr, wc, fr, fq, (bf16_t*)(ws + WS_RV), 1024, (pn - 4) * 256, 1.f, 0, 0);
        else if (pn < 12) body<1>(acc, u, wr, wc, fr, fq, (bf16_t*)(ws + WS_RG), 1024, (pn - 8) * 256, 1.f, 0, 0);
        else if (pn < 15) body<0>(acc, u, wr, wc, fr, fq, (bf16_t*)(ws + WS_AQ), 768, (pn - 12) * 256, 0.125f * 1.4426950408889634f, 0, 0);
        else if (pn < 18) body<3>(acc, u, wr, wc, fr, fq, (bf16_t*)(ws + WS_AK), 768, (pn - 15) * 256, 1.f, pn - 15, 0);
        else if (pn < 21) body<3>(acc, u, wr, wc, fr, fq, (bf16_t*)(ws + WS_AV), 768, (pn - 18) * 256, 1.f, pn - 18, 1);
        else if (pn < 25) body<2>(acc, u, wr, wc, fr, fq, (bf16_t*)(ws + WS_GR), 1024, (pn - 21) * 256, 1.f, 0, 0);
        else body<2>(acc, u, wr, wc, fr, fq, (bf16_t*)(ws + WS_GA), 1024, (pn - 25) * 256, 1.f, 0, 0);
    }
};
struct EpiAbr {
    static constexpr bool PERM = true, AFTER_DRAIN = false, ADJ = false;
    unsigned char* ws;
    __device__ __forceinline__ void small(int n, int c, f32x4 v) const { const size_t o = ((size_t)MPR + n) * DM + c; const u32x2 gw = *(const u32x2*)((const bf16_t*)(ws + WS_GA) + o);
        const f32x4 r = v * (f32x4){bf_lo(gw.x), bf_hi(gw.x), bf_lo(gw.y), bf_hi(gw.y)}; u32x2 w; w.x = cvt_pk_bf16(r[0], r[1]); w.y = cvt_pk_bf16(r[2], r[3]); *(u32x2*)((bf16_t*)(ws + WS_ABR) + o) = w; }
    __device__ __forceinline__ void operator()(const f32x4 (&acc)[2][2][4][2], const Unit& u, int wr, int wc, int fr_, int fq_) const {
        int fr = fr_, fq = fq_; asm volatile("" : "+v"(fr), "+v"(fq));
        const bf16_t* GA = (const bf16_t*)(ws + WS_GA); bf16_t* ABR = (bf16_t*)(ws + WS_ABR);
        const int row0 = u.pm * BM + wr * 64 + fr, col0 = u.pn * BM + wc * 32 + 8 * fq;
        u32x4 gq[2][2];
#pragma unroll
        for (int bj = 0; bj < 2; ++bj) gq[0][bj] = *(const u32x4*)(GA + (size_t)row0 * DM + col0 + bj * HALF);
#pragma unroll
        for (int gi = 0; gi < 8; ++gi) { const int ai = gi >> 2, m = gi & 3; const size_t off = (size_t)(row0 + ai * HALF + m * 16) * DM + col0;
            if (gi < 7) { const int ai2 = (gi + 1) >> 2, m2 = (gi + 1) & 3; const size_t off2 = (size_t)(row0 + ai2 * HALF + m2 * 16) * DM + col0;
#pragma unroll
                for (int bj = 0; bj < 2; ++bj) gq[(gi + 1) & 1][bj] = *(const u32x4*)(GA + off2 + bj * HALF); }
#pragma unroll
            for (int bj = 0; bj < 2; ++bj) { const u32x4 gw = gq[gi & 1][bj];
                const f32x4 v0 = acc[ai][bj][m][0] * (f32x4){bf_lo(gw.x), bf_hi(gw.x), bf_lo(gw.y), bf_hi(gw.y)}, v1 = acc[ai][bj][m][1] * (f32x4){bf_lo(gw.z), bf_hi(gw.z), bf_lo(gw.w), bf_hi(gw.w)};
                u32x4 w; w.x = cvt_pk_bf16(v0[0], v0[1]); w.y = cvt_pk_bf16(v0[2], v0[3]); w.z = cvt_pk_bf16(v1[0], v1[1]); w.w = cvt_pk_bf16(v1[2], v1[3]);
                *(u32x4*)(ABR + off + bj * HALF) = w; } }
    }
};
struct EpiRbr {
    static constexpr bool PERM = true, AFTER_DRAIN = false, ADJ = false;
    unsigned char* ws;
    __device__ __forceinline__ void small(int n, int c, f32x4 v) const { const size_t o = ((size_t)MPR + n) * DM + c; const u32x2 gw = *(const u32x2*)((const bf16_t*)(ws + WS_GR) + o), aw = *(const u32x2*)((const bf16_t*)(ws + WS_ABR) + o);
        const f32x4 r = v * (f32x4){bf_lo(gw.x), bf_hi(gw.x), bf_lo(gw.y), bf_hi(gw.y)} + (f32x4){bf_lo(aw.x), bf_hi(aw.x), bf_lo(aw.y), bf_hi(aw.y)};
        u32x2 w; w.x = cvt_pk_bf16(r[0], r[1]); w.y = cvt_pk_bf16(r[2], r[3]); *(u32x2*)((bf16_t*)(ws + WS_MG) + o) = w; }
    __device__ __forceinline__ void operator()(const f32x4 (&acc)[2][2][4][2], const Unit& u, int wr, int wc, int fr_, int fq_) const {
        int fr = fr_, fq = fq_; asm volatile("" : "+v"(fr), "+v"(fq));
        const bf16_t* GR = (const bf16_t*)(ws + WS_GR); const bf16_t* ABR = (const bf16_t*)(ws + WS_ABR); bf16_t* MG = (bf16_t*)(ws + WS_MG);
        const int row0 = u.pm * BM + wr * 64 + fr, col0 = u.pn * BM + wc * 32 + 8 * fq;
        u32x4 gq[2][2], aq[2][2];
#pragma unroll
        for (int bj = 0; bj < 2; ++bj) { gq[0][bj] = *(const u32x4*)(GR + (size_t)row0 * DM + col0 + bj * HALF); aq[0][bj] = *(const u32x4*)(ABR + (size_t)row0 * DM + col0 + bj * HALF); }
#pragma unroll
        for (int gi = 0; gi < 8; ++gi) { const int ai = gi >> 2, m = gi & 3; const size_t off = (size_t)(row0 + ai * HALF + m * 16) * DM + col0;
            if (gi < 7) { const int ai2 = (gi + 1) >> 2, m2 = (gi + 1) & 3; const size_t off2 = (size_t)(row0 + ai2 * HALF + m2 * 16) * DM + col0;
#pragma unroll
                for (int bj = 0; bj < 2; ++bj) { gq[(gi + 1) & 1][bj] = *(const u32x4*)(GR + off2 + bj * HALF); aq[(gi + 1) & 1][bj] = *(const u32x4*)(ABR + off2 + bj * HALF); } }
#pragma unroll
            for (int bj = 0; bj < 2; ++bj) { const u32x4 gw = gq[gi & 1][bj], aw = aq[gi & 1][bj];
                const f32x4 v0 = acc[ai][bj][m][0] * (f32x4){bf_lo(gw.x), bf_hi(gw.x), bf_lo(gw.y), bf_hi(gw.y)} + (f32x4){bf_lo(aw.x), bf_hi(aw.x), bf_lo(aw.y), bf_hi(aw.y)};
                const f32x4 v1 = acc[ai][bj][m][1] * (f32x4){bf_lo(gw.z), bf_hi(gw.z), bf_lo(gw.w), bf_hi(gw.w)} + (f32x4){bf_lo(aw.z), bf_hi(aw.z), bf_lo(aw.w), bf_hi(aw.w)};
                u32x4 w; w.x = cvt_pk_bf16(v0[0], v0[1]); w.y = cvt_pk_bf16(v0[2], v0[3]); w.z = cvt_pk_bf16(v1[0], v1[1]); w.w = cvt_pk_bf16(v1[2], v1[3]);
                *(u32x4*)(MG + off + bj * HALF) = w; } }
    }
};
struct EpiResid {
    static constexpr bool PERM = true, AFTER_DRAIN = false, ADJ = false;
    bf16_t* XB; float* ssp; float* sss;
    __device__ __forceinline__ void small(int n, int c, f32x4 v) const { const size_t o = ((size_t)MPR + n) * DM + c; const u32x2 b = *(const u32x2*)(XB + o);
        const f32x4 x = (f32x4){bf_lo(b.x), bf_hi(b.x), bf_lo(b.y), bf_hi(b.y)} + v;
        u32x2 w; w.x = cvt_pk_bf16(x[0], x[1]); w.y = cvt_pk_bf16(x[2], x[3]); *(u32x2*)(XB + o) = w;
        float s = (x[0] * x[0] + x[1] * x[1]) + (x[2] * x[2] + x[3] * x[3]); s += __shfl_xor(s, 16); s += __shfl_xor(s, 32);
        if ((lane_id() & 48) == 0) __hip_atomic_fetch_add(sss + n, s, __ATOMIC_RELAXED, __HIP_MEMORY_SCOPE_AGENT); }
    __device__ __forceinline__ void operator()(const f32x4 (&acc)[2][2][4][2], const Unit& u, int wr, int wc, int fr_, int fq_) const {
        int fr = fr_, fq = fq_; asm volatile("" : "+v"(fr), "+v"(fq));
        const int row0 = u.pm * BM + wr * 64 + fr, col0 = u.pn * BM + wc * 32 + 8 * fq;
        u32x4 bq[2][2];
#pragma unroll
        for (int bj = 0; bj < 2; ++bj) bq[0][bj] = *(const u32x4*)(XB + (size_t)row0 * DM + col0 + bj * HALF);
#pragma unroll
        for (int gi = 0; gi < 8; ++gi) { const int ai = gi >> 2, m = gi & 3, row = row0 + ai * HALF + m * 16; const size_t off = (size_t)row * DM + col0; float s = 0.f;
            if (gi < 7) { const int ai2 = (gi + 1) >> 2, m2 = (gi + 1) & 3; const size_t off2 = (size_t)(row0 + ai2 * HALF + m2 * 16) * DM + col0;
#pragma unroll
                for (int bj = 0; bj < 2; ++bj) bq[(gi + 1) & 1][bj] = *(const u32x4*)(XB + off2 + bj * HALF); }
#pragma unroll
            for (int bj = 0; bj < 2; ++bj) { const u32x4 b = bq[gi & 1][bj];
                const f32x4 x0 = (f32x4){bf_lo(b.x), bf_hi(b.x), bf_lo(b.y), bf_hi(b.y)} + acc[ai][bj][m][0], x1 = (f32x4){bf_lo(b.z), bf_hi(b.z), bf_lo(b.w), bf_hi(b.w)} + acc[ai][bj][m][1];
                u32x4 w; w.x = cvt_pk_bf16(x0[0], x0[1]); w.y = cvt_pk_bf16(x0[2], x0[3]); w.z = cvt_pk_bf16(x1[0], x1[1]); w.w = cvt_pk_bf16(x1[2], x1[3]);
                *(u32x4*)(XB + off + bj * HALF) = w;
                s += ((x0[0] * x0[0] + x0[1] * x0[1]) + (x0[2] * x0[2] + x0[3] * x0[3])) + ((x1[0] * x1[0] + x1[1] * x1[1]) + (x1[2] * x1[2] + x1[3] * x1[3])); }
            s += __shfl_xor(s, 16); s += __shfl_xor(s, 32);
            if (fq == 0) __hip_atomic_fetch_add(ssp + row, s, __ATOMIC_RELAXED, __HIP_MEMORY_SCOPE_AGENT);
        }
    }
};
struct EpiResidFinal {
    static constexpr bool PERM = true, AFTER_DRAIN = false, ADJ = false;
    const bf16_t* XB; float* ssp; float* yp; const float* gfin; unsigned* pan; unsigned* tmo;
    __device__ __forceinline__ void operator()(f32x4 (&acc)[2][2][4][2], const Unit& u, int wr, int wc, int fr_, int fq_) const {
        int fr = fr_, fq = fq_; asm volatile("" : "+v"(fr), "+v"(fq));
        const int row0 = u.pm * BM + wr * 64 + fr, col0 = u.pn * BM + wc * 32 + 8 * fq;
        u32x4 bq[2][2];
#pragma unroll
        for (int bj = 0; bj < 2; ++bj) bq[0][bj] = *(const u32x4*)(XB + (size_t)row0 * DM + col0 + bj * HALF);
#pragma unroll
        for (int gi = 0; gi < 8; ++gi) { const int ai = gi >> 2, m = gi & 3, row = row0 + ai * HALF + m * 16; float s = 0.f;
            if (gi < 7) { const int ai2 = (gi + 1) >> 2, m2 = (gi + 1) & 3; const size_t off2 = (size_t)(row0 + ai2 * HALF + m2 * 16) * DM + col0;
#pragma unroll
                for (int bj = 0; bj < 2; ++bj) bq[(gi + 1) & 1][bj] = *(const u32x4*)(XB + off2 + bj * HALF); }
#pragma unroll
            for (int bj = 0; bj < 2; ++bj) { const u32x4 b = bq[gi & 1][bj];
                const f32x4 x0 = (f32x4){bf_lo(b.x), bf_hi(b.x), bf_lo(b.y), bf_hi(b.y)} + acc[ai][bj][m][0], x1 = (f32x4){bf_lo(b.z), bf_hi(b.z), bf_lo(b.w), bf_hi(b.w)} + acc[ai][bj][m][1];
                acc[ai][bj][m][0] = x0; acc[ai][bj][m][1] = x1;
                s += ((x0[0] * x0[0] + x0[1] * x0[1]) + (x0[2] * x0[2] + x0[3] * x0[3])) + ((x1[0] * x1[0] + x1[1] * x1[1]) + (x1[2] * x1[2] + x1[3] * x1[3])); }
            s += __shfl_xor(s, 16); s += __shfl_xor(s, 32);
            if (fq == 0) __hip_atomic_fetch_add(ssp + row, s, __ATOMIC_RELAXED, __HIP_MEMORY_SCOPE_AGENT); }
        asm volatile("s_waitcnt vmcnt(0)" ::: "memory");
        __builtin_amdgcn_s_barrier();
        if (wr == 0 && wc == 0 && lane_id() == 0) {
            unsigned* cnt = pan + 16 * u.pm;
            __hip_atomic_fetch_add(cnt, 1u, __ATOMIC_RELAXED, __HIP_MEMORY_SCOPE_AGENT);
            unsigned sp = 0u;
            while (__hip_atomic_load(cnt, __ATOMIC_RELAXED, __HIP_MEMORY_SCOPE_AGENT) < 4u) { __builtin_amdgcn_s_sleep(1);
                if ((++sp & 255u) == 0u) { if (__hip_atomic_load(tmo, __ATOMIC_RELAXED, __HIP_MEMORY_SCOPE_AGENT)) break; if (sp > (1u << 18)) { atomicAdd(tmo, 1u); break; } } }
        }
        asm volatile("s_waitcnt vmcnt(0)" ::: "memory");
        __builtin_amdgcn_s_barrier();
        f32x4 gg[2][2];
#pragma unroll
        for (int bj = 0; bj < 2; ++bj) { gg[bj][0] = *(const f32x4*)(gfin + col0 + bj * HALF); gg[bj][1] = *(const f32x4*)(gfin + col0 + bj * HALF + 4); }
        float ssv[8];
#pragma unroll
        for (int gi = 0; gi < 8; ++gi) ssv[gi] = __hip_atomic_load(ssp + row0 + (gi >> 2) * HALF + (gi & 3) * 16, __ATOMIC_RELAXED, __HIP_MEMORY_SCOPE_AGENT);
#pragma unroll
        for (int gi = 0; gi < 8; ++gi) { const int ai = gi >> 2, m = gi & 3, row = row0 + ai * HALF + m * 16; const float rs = __builtin_amdgcn_rsqf(ssv[gi] * (1.f / DM) + RMS_EPS);
#pragma unroll
            for (int bj = 0; bj < 2; ++bj) { float* o = yp + (size_t)row * DM + col0 + bj * HALF;
                *(f32x4*)o = acc[ai][bj][m][0] * rs * gg[bj][0]; *(f32x4*)(o + 4) = acc[ai][bj][m][1] * rs * gg[bj][1]; } }
    }
};
struct EpiSwiglu {
    static constexpr bool PERM = true, AFTER_DRAIN = false, ADJ = false;
    bf16_t* H; const float* ssp; const float* sss; int rs_row0;
    __device__ __forceinline__ void small2(int n, int j, f32x4 g, f32x4 up) const { f32x4 r; const float rs = row_rs_s(sss, n); g = g * rs; up = up * rs;
#pragma unroll
        for (int i = 0; i < 4; ++i) r[i] = g[i] * fast_sigmoid(g[i]) * up[i];
        u32x2 w; w.x = cvt_pk_bf16(r[0], r[1]); w.y = cvt_pk_bf16(r[2], r[3]); *(u32x2*)(H + ((size_t)MPR + n) * DFF + j) = w; }
    __device__ __forceinline__ void operator()(const f32x4 (&acc)[2][2][4][2], const Unit& u, int wr, int wc, int fr_, int fq_) const {
        int fr = fr_, fq = fq_; asm volatile("" : "+v"(fr), "+v"(fq));
        const int nai = u.half < 0 ? 2 : 1;
        const int row0 = u.pm * BM + (u.half > 0 ? HALF : 0) + wr * 64 + fr, col0 = u.pn * HALF + wc * 32 + 8 * fq;
        const int tb = ((unsigned)(u.pm * BM - rs_row0) < (unsigned)RS_LDS_ROWS) ? u.pm * BM - rs_row0 : RS_LDS_ROWS;
        float rsv[2][4];
#pragma unroll
        for (int ai = 0; ai < 2; ++ai)
#pragma unroll
            for (int m = 0; m < 4; ++m) { const int row = row0 + ai * HALF + m * 16; rsv[ai][m] = (ai < nai) ? (rs_row0 >= 0 ? rs_tab(row - u.pm * BM + tb) : row_rs(ssp, row)) : 0.f; }
#pragma unroll
        for (int ai = 0; ai < 2; ++ai) if (ai < nai)
#pragma unroll
            for (int m = 0; m < 4; ++m) { f32x4 v0, v1; const float rs = rsv[ai][m];
#pragma unroll
                for (int j = 0; j < 4; ++j) { const float g0 = acc[ai][0][m][0][j] * rs, g1 = acc[ai][0][m][1][j] * rs; v0[j] = g0 * fast_sigmoid(g0) * (acc[ai][1][m][0][j] * rs); v1[j] = g1 * fast_sigmoid(g1) * (acc[ai][1][m][1][j] * rs); }
                u32x4 w; w.x = cvt_pk_bf16(v0[0], v0[1]); w.y = cvt_pk_bf16(v0[2], v0[3]); w.z = cvt_pk_bf16(v1[0], v1[1]); w.w = cvt_pk_bf16(v1[2], v1[3]);
                *(u32x4*)(H + (size_t)(row0 + ai * HALF + m * 16) * DFF + col0) = w; }
    }
};
template <class Epi, class Sched, bool ALIGN_EPI = false, bool SP2 = false>
__device__ __forceinline__ void gemm_phase(PG8_LAS unsigned char* lds, const Gemm g, const Sched& S, const Epi& E, const int wave0) {
    int tid_ = wave0 * 64 + lane_id(); asm volatile("" : "+v"(tid_));
    const int tid = tid_, wid = __builtin_amdgcn_readfirstlane(tid >> 6), lane = tid & 63, wr = wid >> 2, wc = wid & 3, fr = lane & 15, fq = lane >> 4;
    const int K = g.K, nt = K / BK;
    unsigned voffA[2], voffB[2];
#pragma unroll
    for (int i = 0; i < 2; ++i) { int R, C; stage_rc(tid * 16 + i * 8192, R, C); const int Rb = Epi::ADJ ? (2 * (R & ~31) + perm32(R & 31)) : (Epi::PERM ? ((R & ~31) + perm32(R & 31)) : R);
        voffA[i] = (unsigned)(R * K + C) * 2u; voffB[i] = (unsigned)(Rb * K + C) * 2u; }
    const size_t kstep = (size_t)(BK * 2);
    const size_t hstep = (size_t)HALF * K * 2;
    const size_t hstepB = Epi::ADJ ? (size_t)32 * K * 2 : hstep;
    const size_t tstep = 2 * hstep;
    const unsigned ldsw = (unsigned)wid * 1024u;
    const int aoff = lds_byte(wr * 64 + fr, fq * 8), boff = lds_byte(wc * 32 + fr, fq * 8);
#define PG8_SA(b, h) (((b) * 2 + (h)) * HTB)
#define PG8_SB(b, h) ((4 + (b) * 2 + (h)) * HTB)
#define PG8_STAGE(bufoff, gbase, voff) do { _Pragma("unroll") for (int _i = 0; _i < 2; ++_i) \
        __builtin_amdgcn_global_load_lds((const unsigned*)((const char*)(gbase) + (voff)[_i]), (PG8_LAS unsigned*)(lds + (bufoff) + ldsw + _i * 8192), 16, 0, 0); } while (0)
#define PG8_LDA(dst, b, h) do { _Pragma("unroll") for (int m = 0; m < 4; ++m) _Pragma("unroll") for (int k = 0; k < 2; ++k) dst[m][k] = *(const PG8_LAS bf16x8*)(lds + PG8_SA(b, h) + aoff + m * 2048 + k * 1024); } while (0)
#define PG8_LDB(dst, b, h) do { _Pragma("unroll") for (int n = 0; n < 2; ++n) _Pragma("unroll") for (int k = 0; k < 2; ++k) dst[n][k] = *(const PG8_LAS bf16x8*)(lds + PG8_SB(b, h) + boff + n * 2048 + k * 1024); } while (0)
#define PG8_MMA(ai, bj, At, Bt) do { __builtin_amdgcn_s_setprio(1); _Pragma("unroll") for (int m = 0; m < 4; ++m) _Pragma("unroll") for (int n = 0; n < 2; ++n) _Pragma("unroll") for (int k = 0; k < 2; ++k) \
        acc[ai][bj][m][n] = __builtin_amdgcn_mfma_f32_16x16x32_bf16(Bt[n][k], At[m][k], acc[ai][bj][m][n], 0, 0, 0); __builtin_amdgcn_s_setprio(0); } while (0)
#define PG8_WAIT_V(n) asm volatile("s_waitcnt vmcnt(" #n ")" ::: "memory")
#define PG8_WAIT_L(n) asm volatile("s_waitcnt lgkmcnt(" #n ")" ::: "memory")
#define PG8_BAR __builtin_amdgcn_s_barrier()
#define PG8_SCHED __builtin_amdgcn_sched_barrier(0)
    Unit cur, nxt; int ui = 0;
    if (!S.next(0, cur)) return;
    f32x4 acc[2][2][4][2];
#pragma unroll
    for (int a = 0; a < 2; ++a)
#pragma unroll
        for (int b = 0; b < 2; ++b)
#pragma unroll
            for (int m = 0; m < 4; ++m)
#pragma unroll
                for (int n = 0; n < 2; ++n) acc[a][b][m][n] = (f32x4){0.f, 0.f, 0.f, 0.f};
    bf16x8 At[4][2], B0[2][2], B1[2][2];
    const char* cA = (const char*)g.A + (size_t)cur.pm * tstep + (cur.half > 0 ? hstep : (size_t)0); const char* cB = (const char*)g.Bt + (size_t)cur.pn * tstep;
    S.a_ready(cur);
    if constexpr (SP2) {
        PG8_STAGE(PG8_SB(0, 0), cB, voffB); PG8_STAGE(PG8_SB(0, 1), cB + hstepB, voffB); PG8_STAGE(PG8_SA(0, 0), cA, voffA); PG8_STAGE(PG8_SA(0, 1), cA + hstep, voffA);
        if (wr == 1) PG8_BAR;
        PG8_WAIT_V(2); PG8_BAR;
        PG8_STAGE(PG8_SB(1, 0), cB + kstep, voffB); PG8_STAGE(PG8_SA(1, 0), cA + kstep, voffA); PG8_STAGE(PG8_SB(1, 1), cB + hstepB + kstep, voffB);
        PG8_WAIT_V(6); PG8_BAR;
    } else {
        PG8_STAGE(PG8_SB(0, 0), cB, voffB); PG8_STAGE(PG8_SA(0, 0), cA, voffA); PG8_STAGE(PG8_SB(0, 1), cB + hstepB, voffB); PG8_STAGE(PG8_SA(0, 1), cA + hstep, voffA);
        if (wr == 1) PG8_BAR;
        PG8_WAIT_V(4); PG8_BAR;
        PG8_STAGE(PG8_SB(1, 0), cB + kstep, voffB); PG8_STAGE(PG8_SA(1, 0), cA + kstep, voffA); PG8_STAGE(PG8_SB(1, 1), cB + hstepB + kstep, voffB);
        PG8_WAIT_V(6); PG8_BAR;
    }
    for (;;) {
        const bool has_next = S.next(ui + 1, nxt);
        const char* nA = has_next ? (const char*)g.A + (size_t)nxt.pm * tstep + (nxt.half > 0 ? hstep : (size_t)0) : cA; const char* nB = has_next ? (const char*)g.Bt + (size_t)nxt.pn * tstep : cB;
        const bool full = cur.half < 0;
#pragma unroll 1
        for (int t = 0; t < nt; t += 2) {
            const bool last = (t == nt - 2);
            const char* a1 = cA + (size_t)(t + 1) * kstep;
            const char* a2 = last ? nA : cA + (size_t)(t + 2) * kstep; const char* b2 = last ? nB : cB + (size_t)(t + 2) * kstep;
            const char* a3 = a2 + kstep; const char* b3 = b2 + kstep;
            if (last && has_next) S.a_ready(nxt);
            if constexpr (SP2) {
            PG8_LDB(B0, 0, 0); PG8_LDB(B1, 0, 1); PG8_SCHED; PG8_LDA(At, 0, 0); PG8_STAGE(PG8_SA(1, 1), a1 + hstep, voffA);
            PG8_WAIT_V(8); PG8_WAIT_L(0); PG8_BAR; PG8_MMA(0, 0, At, B0); PG8_MMA(0, 1, At, B1); PG8_BAR; PG8_SCHED;
            PG8_LDA(At, 0, 1); PG8_STAGE(PG8_SB(0, 0), b2, voffB); PG8_STAGE(PG8_SB(0, 1), b2 + hstepB, voffB); PG8_STAGE(PG8_SA(0, 0), a2, voffA);
            PG8_WAIT_V(8); PG8_WAIT_L(0); PG8_BAR; if (full) { PG8_MMA(1, 0, At, B0); PG8_MMA(1, 1, At, B1); } PG8_BAR; PG8_SCHED;
            PG8_LDB(B0, 1, 0); PG8_LDB(B1, 1, 1); PG8_SCHED; PG8_LDA(At, 1, 0); PG8_STAGE(PG8_SA(0, 1), a2 + hstep, voffA);
            PG8_WAIT_V(8); PG8_WAIT_L(0); PG8_BAR; PG8_MMA(0, 0, At, B0); PG8_MMA(0, 1, At, B1); PG8_BAR; PG8_SCHED;
            PG8_LDA(At, 1, 1); PG8_STAGE(PG8_SB(1, 0), b3, voffB); PG8_STAGE(PG8_SB(1, 1), b3 + hstepB, voffB); PG8_STAGE(PG8_SA(1, 0), a3, voffA);
            PG8_WAIT_V(8); PG8_WAIT_L(0); PG8_BAR; if (full) { PG8_MMA(1, 0, At, B0); PG8_MMA(1, 1, At, B1); } PG8_BAR; PG8_SCHED;
            } else {
            PG8_LDB(B0, 0, 0); PG8_SCHED; PG8_LDA(At, 0, 0); PG8_STAGE(PG8_SA(1, 1), a1 + hstep, voffA);
            PG8_WAIT_L(8); PG8_BAR; PG8_WAIT_L(0); PG8_MMA(0, 0, At, B0); PG8_BAR; PG8_SCHED;
            PG8_LDB(B1, 0, 1); PG8_STAGE(PG8_SB(0, 0), b2, voffB);
            PG8_BAR; PG8_WAIT_L(0); PG8_MMA(0, 1, At, B1); PG8_BAR;
            PG8_LDA(At, 0, 1); PG8_STAGE(PG8_SA(0, 0), a2, voffA);
            PG8_BAR; PG8_WAIT_L(0); PG8_MMA(1, 0, At, B0); PG8_BAR; PG8_SCHED;
            PG8_STAGE(PG8_SB(0, 1), b2 + hstepB, voffB);
            PG8_WAIT_V(6); PG8_BAR; PG8_MMA(1, 1, At, B1); PG8_BAR;
            PG8_LDB(B0, 1, 0); PG8_SCHED; PG8_LDA(At, 1, 0); PG8_STAGE(PG8_SA(0, 1), a2 + hstep, voffA);
            PG8_WAIT_L(8); PG8_BAR; PG8_WAIT_L(0); PG8_MMA(0, 0, At, B0); PG8_BAR; PG8_SCHED;
            PG8_LDB(B1, 1, 1); PG8_STAGE(PG8_SB(1, 0), b3, voffB);
            PG8_BAR; PG8_WAIT_L(0); PG8_MMA(0, 1, At, B1); PG8_BAR;
            PG8_LDA(At, 1, 1); PG8_STAGE(PG8_SA(1, 0), a3, voffA);
            PG8_BAR; PG8_WAIT_L(0); PG8_MMA(1, 0, At, B0); PG8_BAR; PG8_SCHED;
            PG8_STAGE(PG8_SB(1, 1), b3 + hstepB, voffB);
            PG8_WAIT_V(6); PG8_BAR; PG8_MMA(1, 1, At, B1); PG8_BAR;
            }
        }
        if constexpr (ALIGN_EPI) { if (wr == 0) PG8_BAR; }
        if constexpr (!Epi::AFTER_DRAIN) { E(acc, cur, wr, wc, fr, fq); S.done(cur); }
        if (!has_next) break;
#pragma unroll
        for (int a = 0; a < 2; ++a)
#pragma unroll
            for (int b = 0; b < 2; ++b)
#pragma unroll
                for (int m = 0; m < 4; ++m)
#pragma unroll
                    for (int n = 0; n < 2; ++n) acc[a][b][m][n] = (f32x4){0.f, 0.f, 0.f, 0.f};
        cur = nxt; cA = nA; cB = nB; ++ui;
        if constexpr (ALIGN_EPI) { if (wr == 1) PG8_BAR; }
    }
    PG8_WAIT_V(0);
    if constexpr (!ALIGN_EPI) { if (wr == 0) PG8_BAR; }
    PG8_BAR;
    if constexpr (Epi::AFTER_DRAIN) { E.fused(acc, cur, wr, wc, fr, fq, lds, wid, lane); S.done(cur); }
#undef PG8_SA
#undef PG8_SB
#undef PG8_STAGE
#undef PG8_LDA
#undef PG8_LDB
#undef PG8_MMA
#undef PG8_WAIT_V
#undef PG8_WAIT_L
#undef PG8_BAR
#undef PG8_SCHED
}
}
#define GAS __attribute__((address_space(1)))
#define LAS __attribute__((address_space(3)))
typedef unsigned short bf16;
typedef unsigned v4u __attribute__((ext_vector_type(4)));
typedef float f32x4 __attribute__((ext_vector_type(4)));
typedef short bf16x8 __attribute__((ext_vector_type(8)));
typedef GAS unsigned gu32;
typedef GAS unsigned long long gu64;
#define RLX_AGENT __ATOMIC_RELAXED, __HIP_MEMORY_SCOPE_AGENT
#define LDS_WAIT() asm volatile("s_waitcnt lgkmcnt(0)" ::: "memory")
#define VM_WAIT() asm volatile("s_waitcnt vmcnt(0)" ::: "memory")
__device__ __forceinline__ unsigned long long rt() { return __builtin_amdgcn_s_memrealtime(); }
__device__ __forceinline__ unsigned f2bf(float f) { unsigned u = __builtin_bit_cast(unsigned, f); return (u + 0x7fffu + ((u >> 16) & 1u)) >> 16; }
__device__ __forceinline__ unsigned pk2(float lo, float hi) { return f2bf(lo) | (f2bf(hi) << 16); }

#define XB_TMO      128
#define XB_XCNT(j)  (256  + 64 * (j))
#define XB_XSUB(j)  (1280 + 64 * (j))
#define XB_XGEN(j)  (2304 + 64 * (j))
#define XB_TOP      3328
#define XB_TOPGEN   3392
#define XCD_BAR_WORDS 3456
#define XB_SPIN_CAP (1u << 18)

__device__ __forceinline__ unsigned xb_ld(unsigned* p)              { return __hip_atomic_load(p, __ATOMIC_RELAXED, __HIP_MEMORY_SCOPE_AGENT); }
__device__ __forceinline__ unsigned xb_add(unsigned* p, unsigned v) { return __hip_atomic_fetch_add(p, v, __ATOMIC_RELAXED, __HIP_MEMORY_SCOPE_AGENT); }
__device__ __forceinline__ unsigned xb_xcc_id() { return (unsigned)__builtin_amdgcn_s_getreg((3 << 11) | 20) & 0xFu; }
#define XB_SPIN(cond, bar) do { unsigned _sp = 0; while (cond) { __builtin_amdgcn_s_sleep(1); \
    if ((++_sp & 255u) == 0u) { if (xb_ld(&(bar)[XB_TMO])) break; if (_sp > XB_SPIN_CAP) { atomicAdd(&(bar)[XB_TMO], 1u); break; } } } } while (0)

struct XcdBarrier {
    unsigned* bar; unsigned x; unsigned w0;
    volatile LAS unsigned* st;
};

__device__ __forceinline__ XcdBarrier xcd_barrier_post(unsigned* bar, volatile LAS unsigned* st) {
    XcdBarrier b; b.bar = bar; b.x = xb_xcc_id(); b.st = st; b.w0 = (unsigned)__builtin_amdgcn_readfirstlane((int)(threadIdx.x >> 6));
    if (threadIdx.x == 0) (void)xb_add(&bar[XB_XCNT(b.x)], 1u);
    return b;
}
__device__ __forceinline__ void xcd_barrier_complete(unsigned* bar, unsigned x, unsigned& nloc, unsigned& nx) {
    const unsigned G = gridDim.x * gridDim.y * gridDim.z;
    unsigned sum, cnt, mine, sp = 0u;
    for (;;) {
        sum = 0u; cnt = 0u; mine = 0u;
#pragma unroll
        for (unsigned j = 0; j < 16; ++j) { const unsigned c = xb_ld(&bar[XB_XCNT(j)]); sum += c; cnt += (c > 0u) ? 1u : 0u; mine = (j == x) ? c : mine; }
        if (sum == G) break;
        __builtin_amdgcn_s_sleep(1);
        if ((++sp & 255u) == 0u) { if (xb_ld(&bar[XB_TMO])) break; if (sp > XB_SPIN_CAP) { atomicAdd(&bar[XB_TMO], 1u); break; } }
    }
    nloc = mine > 0u ? mine : 1u; nx = cnt > 0u ? cnt : 1u;
}

__device__ __forceinline__ void xcd_barrier(const XcdBarrier& b) {
    asm volatile("s_waitcnt vmcnt(0)" ::: "memory");
    __syncthreads();
    if (b.w0 == 0u && lane_id() == 0) {
        unsigned* bar = b.bar;
        __builtin_amdgcn_s_waitcnt(0);
        unsigned nloc = b.st[0], nx = b.st[1];
        if (nloc == 0u) { xcd_barrier_complete(bar, b.x, nloc, nx); b.st[0] = nloc; b.st[1] = nx; }
        const unsigned old = xb_add(&bar[XB_XSUB(b.x)], 1u);
        const unsigned gen = old / nloc;
        if (old + 1u == (gen + 1u) * nloc) {
            __builtin_amdgcn_fence(__ATOMIC_RELEASE, "agent");
            asm volatile("s_waitcnt vmcnt(0)" ::: "memory");
            __builtin_amdgcn_fence(__ATOMIC_ACQUIRE, "agent");
            const unsigned og = xb_add(&bar[XB_TOP], 1u);
            const unsigned tg = og / nx;
            if (og + 1u == (tg + 1u) * nx) xb_add(&bar[XB_TOPGEN], 1u);
            else XB_SPIN(xb_ld(&bar[XB_TOPGEN]) == tg, bar);
            asm volatile("s_waitcnt vmcnt(0)" ::: "memory");
        } else {
            __builtin_amdgcn_fence(__ATOMIC_ACQUIRE, "agent");
            XB_SPIN(xb_ld(&bar[XB_TOPGEN]) <= gen, bar);
            asm volatile("s_waitcnt vmcnt(0)" ::: "memory");
        }
    }
    __syncthreads();
}
__device__ __forceinline__ float wave_sum(float v) {
#pragma unroll
    for (int o = 1; o < 64; o <<= 1) v += __shfl_xor(v, o);
    return v;
}
__device__ __forceinline__ void p0_transpose_item(const float* W, int K, int N, bf16* WT, int row_off, LAS float* scr, int item, int lane) {
    const int nblk = N / 32, kb = item / nblk, nb = item % nblk, k0 = 64 * kb, n0 = 32 * nb;
#pragma unroll 8
    for (int i = 0; i < 32; ++i) { const int kk = 2 * i + (lane >> 5); scr[kk * 33 + (lane & 31)] = W[(size_t)(k0 + kk) * N + n0 + (lane & 31)]; }
    LDS_WAIT(); asm volatile("" ::: "memory");
    const int c = lane & 7;
#pragma unroll
    for (int j = 0; j < 4; ++j) { const int n = (lane >> 3) + 8 * j; const LAS float* s = scr + (8 * c) * 33 + n;
        v4u o; o.x = pk2(s[0 * 33], s[1 * 33]); o.y = pk2(s[2 * 33], s[3 * 33]); o.z = pk2(s[4 * 33], s[5 * 33]); o.w = pk2(s[6 * 33], s[7 * 33]);
        *(GAS v4u*)(WT + (size_t)(row_off + n0 + n) * K + k0 + 8 * c) = o; }
    LDS_WAIT(); asm volatile("" ::: "memory");
}
struct Args { const float* in[15]; float* out; unsigned char* ws; int ph_lo, ph_hi; };
struct Ctx { LAS unsigned char* lds; int tid, lane, wave, vcu, G; };
__device__ __forceinline__ Ctx make_ctx(LAS unsigned char* lds, int wave0) { Ctx F; F.lds = lds; int t = wave0 * 64 + lane_id(); asm volatile("" : "+v"(t)); F.tid = t; F.lane = t & 63; F.wave = wave0;
    F.G = gridDim.x; { const int bx = blockIdx.x; F.vcu = (F.G % 8 == 0) ? (bx % 8) * (F.G / 8) + bx / 8 : bx; } return F; }
struct Ptrs {
    const float *xp, *xs, *state, *c0, *c1, *c2, *norm_mix, *w_in, *w_ret, *w_att, *w_out, *norm_ffn, *w_gu, *w_dn, *norm_final;
    float* out; unsigned char* ws;
    float *XF, *KVC, *SC, *ABR; bf16 *HN, *RQ, *RK, *RV, *RG, *AQ, *AK, *AV, *GR, *GA, *RO, *AO, *MG, *H;
};
typedef const __attribute__((address_space(4))) Args* KArgs;
__device__ __forceinline__ Ptrs late_ptrs() {
    KArgs a = (KArgs)__builtin_amdgcn_kernarg_segment_ptr();
    asm volatile("" : "+s"(a));
    Ptrs P; unsigned char* ws = a->ws; P.ws = ws; P.out = a->out;
    P.xp = a->in[0]; P.xs = a->in[1]; P.state = a->in[2]; P.c0 = a->in[3]; P.c1 = a->in[4]; P.c2 = a->in[5]; P.norm_mix = a->in[6]; P.w_in = a->in[7];
    P.w_ret = a->in[8]; P.w_att = a->in[9]; P.w_out = a->in[10]; P.norm_ffn = a->in[11]; P.w_gu = a->in[12]; P.w_dn = a->in[13]; P.norm_final = a->in[14];
    P.XF = (float*)(ws + WS_XF); P.HN = (bf16*)(ws + WS_HN); P.RQ = (bf16*)(ws + WS_RQ); P.RK = (bf16*)(ws + WS_RK); P.RV = (bf16*)(ws + WS_RV); P.RG = (bf16*)(ws + WS_RG);
    P.AQ = (bf16*)(ws + WS_AQ); P.AK = (bf16*)(ws + WS_AK); P.AV = (bf16*)(ws + WS_AV); P.GR = (bf16*)(ws + WS_GR); P.GA = (bf16*)(ws + WS_GA);
    P.KVC = (float*)(ws + WS_KVC); P.SC = (float*)(ws + WS_SC); P.RO = (bf16*)(ws + WS_RO); P.AO = (bf16*)(ws + WS_AO); P.ABR = (float*)(ws + WS_ABR); P.MG = (bf16*)(ws + WS_MG); P.H = (bf16*)(ws + WS_H);
    return P;
}
__device__ __forceinline__ float bf2f(bf16 b) { return __builtin_bit_cast(float, ((unsigned)b) << 16); }
__device__ __forceinline__ float log_gamma_h(int h) { return log1pf(-exp2f(-5.0f - (float)h)); }

__device__ __forceinline__ void p0_item(const float* W, int K, int N, bf16* WT, LAS float* scr, int kb, int nb, int drow0, int lane, const float* gain = nullptr) {
    const int k0 = 64 * kb, n0 = 32 * nb;
    float wv[32];
#pragma unroll
    for (int i = 0; i < 32; ++i) { const int kk = 2 * i + (lane >> 5); wv[i] = W[(size_t)(k0 + kk) * N + n0 + (lane & 31)]; }
    const float g0 = gain ? gain[k0 + (lane >> 5) + 2 * (lane & 31)] : 1.f;
#pragma unroll
    for (int i = 0; i < 32; ++i) { const int kk = 2 * i + (lane >> 5); scr[kk * 33 + (lane & 31)] = wv[i] * __shfl(g0, i + (lane & 32)); }
    LDS_WAIT(); asm volatile("" ::: "memory");
    const int c = lane & 7;
#pragma unroll
    for (int j = 0; j < 4; ++j) { const int n = (lane >> 3) + 8 * j; const LAS float* s = scr + (8 * c) * 33 + n;
        v4u o; o.x = pk2(s[0 * 33], s[1 * 33]); o.y = pk2(s[2 * 33], s[3 * 33]); o.z = pk2(s[4 * 33], s[5 * 33]); o.w = pk2(s[6 * 33], s[7 * 33]);
        *(GAS v4u*)(WT + (size_t)(drow0 + n) * K + k0 + 8 * c) = o; }
    LDS_WAIT(); asm volatile("" ::: "memory");
}
__device__ __forceinline__ void norm_row(const float* src, const float* g, bf16* orow, float* copy, int lane) {
    f32x4 v[4]; float s = 0.f;
#pragma unroll
    for (int j = 0; j < 4; ++j) { v[j] = src ? ((const GAS f32x4*)src)[lane + 64 * j] : (f32x4){0.f, 0.f, 0.f, 0.f}; s += (v[j].x * v[j].x + v[j].y * v[j].y) + (v[j].z * v[j].z + v[j].w * v[j].w); }
    const float rs = 1.f / sqrtf(wave_sum(s) * (1.f / DM) + RMS_EPS);
    GAS unsigned long long* o8 = (GAS unsigned long long*)orow + lane;
#pragma unroll
    for (int j = 0; j < 4; ++j) { const f32x4 gg = ((const GAS f32x4*)g)[lane + 64 * j];
        if (copy) ((GAS f32x4*)copy)[lane + 64 * j] = v[j];
        o8[64 * j] = (unsigned long long)pk2(v[j].x * rs * gg.x, v[j].y * rs * gg.y) | ((unsigned long long)pk2(v[j].z * rs * gg.z, v[j].w * rs * gg.w) << 32); }
}
constexpr int I_IN = 16 * (DIN / 32), I_RET = 16 * 32, I_ATT = 4 * 32, I_OUT = 16 * 32, I_GU = 16 * (2 * DFF / 32), I_DN = (DFF / 64) * 32, I_LAYER = I_IN + I_RET + I_ATT + I_OUT + I_GU + I_DN;
__device__ __forceinline__ void convert_weights(const Ctx& F, const Ptrs& P, int it_lo, int it_hi, int gw, int NGW) {
    LAS float* scr = (LAS float*)(F.lds + F.wave * 16384);
    for (int it = it_lo + gw; it < it_hi; it += NGW) {
        const int l = it / I_LAYER; int r = it % I_LAYER; unsigned char* wl = P.ws + WS_W + (size_t)l * W_LAYER;
        if (r < I_IN) { const int nblk = DIN / 32; p0_item(P.w_in + (size_t)l * DM * DIN, DM, DIN, (bf16*)(wl + W_IN), scr, r / nblk, r % nblk, 32 * (r % nblk), F.lane, P.norm_mix + (size_t)l * DM); continue; } r -= I_IN;
        if (r < I_RET) { p0_item(P.w_ret + (size_t)l * DM * DM, DM, DM, (bf16*)(wl + W_RET), scr, r / 32, r % 32, 32 * (r % 32), F.lane); continue; } r -= I_RET;
        if (r < I_ATT) { p0_item(P.w_att + (size_t)l * 256 * DM, 256, DM, (bf16*)(wl + W_ATT), scr, r / 32, r % 32, 32 * (r % 32), F.lane); continue; } r -= I_ATT;
        if (r < I_OUT) { p0_item(P.w_out + (size_t)l * DM * DM, DM, DM, (bf16*)(wl + W_OUT), scr, r / 32, r % 32, 32 * (r % 32), F.lane); continue; } r -= I_OUT;
        if (r < I_GU) { const int nblk = 2 * DFF / 32, nb = r % nblk, n0 = 32 * nb; const int isup = n0 >= DFF, nn = isup ? n0 - DFF : n0, drow = 256 * (nn / 128) + 128 * isup + (nn % 128);
            p0_item(P.w_gu + (size_t)l * DM * 2 * DFF, DM, 2 * DFF, (bf16*)(wl + W_GU), scr, r / nblk, nb, drow, F.lane, P.norm_ffn + (size_t)l * DM); continue; } r -= I_GU;
        p0_item(P.w_dn + (size_t)l * DFF * DM, DFF, DM, (bf16*)(wl + W_DN), scr, r / 32, r % 32, 32 * (r % 32), F.lane);
    }
}
__device__ __forceinline__ void ph_prologue(const Ctx& F, const Ptrs& P) {
    const int gw = F.vcu * NWAVES + F.wave, NGW = F.G * NWAVES;
    convert_weights(F, P, 0, I_IN, gw, NGW);
    bf16* XB = (bf16*)(P.ws + WS_XB); float* SSP = (float*)(P.ws + WS_SSP); float* SSS = (float*)(P.ws + WS_SSS);
    for (int m0 = gw; m0 < MR; m0 += 2 * NGW) {
        f32x4 v[2][4];
#pragma unroll
        for (int q = 0; q < 2; ++q) { const int m = m0 + q * NGW; if (m < MR) { const float* src = (m < MPR) ? P.xp + (size_t)m * DM : P.xs + (size_t)(m - MPR) * DM;
#pragma unroll
            for (int j = 0; j < 4; ++j) v[q][j] = ((const GAS f32x4*)src)[F.lane + 64 * j]; } }
#pragma unroll
        for (int q = 0; q < 2; ++q) { const int m = m0 + q * NGW; if (m < MR) { float ss = 0.f;
#pragma unroll
            for (int j = 0; j < 4; ++j) ss += (v[q][j].x * v[q][j].x + v[q][j].y * v[q][j].y) + (v[q][j].z * v[q][j].z + v[q][j].w * v[q][j].w);
            ss = wave_sum(ss);
            GAS unsigned long long* o8 = (GAS unsigned long long*)(XB + (size_t)m * DM) + F.lane;
#pragma unroll
            for (int j = 0; j < 4; ++j) o8[64 * j] = (unsigned long long)pk2(v[q][j].x, v[q][j].y) | ((unsigned long long)pk2(v[q][j].z, v[q][j].w) << 32);
            if (F.lane == 0) { if (m < MPR) SSP[m] = ss; else SSS[m - MPR] = ss; } } } }
    for (int i = F.vcu * NTHR + F.tid; i < 4 * NS; i += F.G * NTHR) SSS[NS + i] = 0.f;
    for (int i = F.vcu * NTHR + F.tid; i < 4 * MPR; i += F.G * NTHR) SSP[MPR + i] = 0.f;
}
__device__ __forceinline__ void ph_rmsnorm(const Ctx& F, const Ptrs& P, const float* g) {
    const int gw = F.vcu * NWAVES + F.wave, NGW = F.G * NWAVES;
    for (int m = gw; m < MP; m += NGW) norm_row(P.XF + (size_t)m * DM, g, P.HN + (size_t)m * DM, nullptr, F.lane);
}
__device__ __forceinline__ void ph_final_norm(const Ctx& F, const Ptrs& P, int m_lo = 0) {
    const int gw = F.vcu * NWAVES + F.wave, NGW = F.G * NWAVES, lane = F.lane;
    const float* SSP = (const float*)(P.ws + WS_SSP) + (size_t)4 * MPR; const float* SSS = (const float*)(P.ws + WS_SSS) + 4 * NS;
    f32x4 gg[4];
#pragma unroll
    for (int j = 0; j < 4; ++j) gg[j] = ((const GAS f32x4*)P.norm_final)[lane + 64 * j];
    const bf16* XB = (const bf16*)(P.ws + WS_XB);
    for (int m0 = m_lo + gw; m0 < MR; m0 += 2 * NGW) {
        unsigned long long v[2][4]; float ssq[2] = {1.f, 1.f};
#pragma unroll
        for (int q = 0; q < 2; ++q) { const int m = m0 + q * NGW; if (m < MR) { const GAS unsigned long long* xr = (const GAS unsigned long long*)(XB + (size_t)m * DM) + lane;
#pragma unroll
            for (int j = 0; j < 4; ++j) v[q][j] = xr[64 * j];
            ssq[q] = (m < MPR) ? SSP[m] : SSS[m - MPR]; } }
#pragma unroll
        for (int q = 0; q < 2; ++q) { const int m = m0 + q * NGW; if (m < MR) { const float rs = 1.f / sqrtf(ssq[q] * (1.f / DM) + RMS_EPS);
            float* orow = (m < MPR) ? P.out + O_YP + (size_t)m * DM : P.out + O_YS + (size_t)(m - MPR) * DM;
#pragma unroll
            for (int j = 0; j < 4; ++j) { const unsigned lo = (unsigned)v[q][j], hi = (unsigned)(v[q][j] >> 32);
                const f32x4 x = (f32x4){bf2f((bf16)(lo & 0xffff)), bf2f((bf16)(lo >> 16)), bf2f((bf16)(hi & 0xffff)), bf2f((bf16)(hi >> 16))};
                ((GAS f32x4*)orow)[lane + 64 * j] = x * rs * gg[j]; } } }
    }
}
typedef short s16x4 __attribute__((ext_vector_type(4)));
typedef short v4i16_t __attribute__((ext_vector_type(4)));
typedef unsigned u32x2v __attribute__((ext_vector_type(2)));
typedef float f32x2s __attribute__((ext_vector_type(2)));
__device__ __forceinline__ f32x4 mfma16(bf16x8 x, bf16x8 y, f32x4 c) { return __builtin_amdgcn_mfma_f32_16x16x32_bf16(x, y, c, 0, 0, 0); }
__device__ __forceinline__ s16x4 tr4(LAS unsigned char* p) { return __builtin_bit_cast(s16x4, __builtin_amdgcn_ds_read_tr16_b64_v4i16((LAS v4i16_t*)p)); }
__device__ __forceinline__ bf16x8 tr_frag(LAS unsigned char* img, int rs, int ra, int rb, int n0, int lane) {
    const int fq = lane >> 4, q = (lane & 15) >> 2, p = lane & 3;
    const s16x4 a = tr4(img + (ra + 4 * fq + q) * rs + (n0 + 4 * p) * 2), b = tr4(img + (rb + 4 * fq + q) * rs + (n0 + 4 * p) * 2);
    return (bf16x8){a[0], a[1], a[2], a[3], b[0], b[1], b[2], b[3]};
}
constexpr int KS_ = 288, VS_ = 544, KIMG = 0, VIMG = 128 * KS_;
static_assert(VIMG + 128 * VS_ <= RING_BYTES, "retention LDS images");
__device__ __forceinline__ void ret_stage_kv(const Ctx& F, const Ptrs& P, size_t row0, int h) {
#pragma unroll
    for (int i = 0; i < 4; ++i) { const int ch = F.tid + i * NTHR, r = ch >> 4, c = ch & 15;
        const v4u x = *(const GAS v4u*)(P.RK + (row0 + r) * 512 + h * 128 + c * 8); *(LAS v4u*)(F.lds + KIMG + r * KS_ + c * 16) = x; }
#pragma unroll
    for (int i = 0; i < 8; ++i) { const int ch = F.tid + i * NTHR, r = ch >> 5, c = ch & 31;
        const v4u x = *(const GAS v4u*)(P.RV + (row0 + r) * 1024 + h * 256 + c * 8); *(LAS v4u*)(F.lds + VIMG + r * VS_ + c * 16) = x; }
}
__device__ __forceinline__ void ph_ret_kv(const Ctx& F, const Ptrs& P) {
    const int lane = F.lane, w = F.wave, fr = lane & 15, fq = lane >> 4;
    v4u pk[4], pv[8];
#define RKV_PREFETCH(U) do { const int u_ = (U), c_ = u_ & 63, h_ = (u_ >> 6) & 3, b_ = u_ >> 8; const size_t r0_ = (size_t)b_ * T + (size_t)c_ * RCH; \
        _Pragma("unroll") for (int i = 0; i < 4; ++i) { const int ch = F.tid + i * NTHR, r = ch >> 4, c = ch & 15; pk[i] = *(const GAS v4u*)(P.RK + (r0_ + r) * 512 + h_ * 128 + c * 8); } \
        _Pragma("unroll") for (int i = 0; i < 8; ++i) { const int ch = F.tid + i * NTHR, r = ch >> 5, c = ch & 31; pv[i] = *(const GAS v4u*)(P.RV + (r0_ + r) * 1024 + h_ * 256 + c * 8); } } while (0)
    if ((int)blockIdx.x < 512) RKV_PREFETCH((int)blockIdx.x);
    for (int u = blockIdx.x; u < 512; u += F.G) {
        __syncthreads();
#pragma unroll
        for (int i = 0; i < 4; ++i) { const int ch = F.tid + i * NTHR, r = ch >> 4, c = ch & 15; *(LAS v4u*)(F.lds + KIMG + r * KS_ + c * 16) = pk[i]; }
#pragma unroll
        for (int i = 0; i < 8; ++i) { const int ch = F.tid + i * NTHR, r = ch >> 5, c = ch & 31; *(LAS v4u*)(F.lds + VIMG + r * VS_ + c * 16) = pv[i]; }
        if (u + F.G < 512) RKV_PREFETCH(u + F.G);
        asm volatile("s_waitcnt lgkmcnt(0)" ::: "memory"); __builtin_amdgcn_s_barrier(); asm volatile("" ::: "memory");
        f32x4 acc[2][8];
#pragma unroll
        for (int a = 0; a < 2; ++a)
#pragma unroll
            for (int d = 0; d < 8; ++d) acc[a][d] = (f32x4){0.f, 0.f, 0.f, 0.f};
#pragma unroll
        for (int ks = 0; ks < 4; ++ks) {
            bf16x8 xv[2];
#pragma unroll
            for (int a = 0; a < 2; ++a) xv[a] = tr_frag(F.lds + VIMG, VS_, 32 * ks, 32 * ks + 16, 16 * (2 * w + a), lane);
            bf16x8 yk[8];
#pragma unroll
            for (int d = 0; d < 8; ++d) yk[d] = tr_frag(F.lds + KIMG, KS_, 32 * ks, 32 * ks + 16, 16 * d, lane);
#pragma unroll
            for (int d = 0; d < 8; ++d)
#pragma unroll
                for (int a = 0; a < 2; ++a) acc[a][d] = mfma16(xv[a], yk[d], acc[a][d]);
        }
        float* o = P.KVC + (size_t)u * 32768;
#pragma unroll
        for (int a = 0; a < 2; ++a)
#pragma unroll
            for (int d = 0; d < 8; ++d)
#pragma unroll
                for (int r = 0; r < 4; ++r) o[(size_t)(16 * (2 * w + a) + 4 * fq + r) * 128 + 16 * d + fr] = acc[a][d][r];
    }
#undef RKV_PREFETCH
}
__device__ __forceinline__ void ph_ret_scan(const Ctx& F, const Ptrs& P, int layer, int vb, int VG) {
    bf16* SCT = (bf16*)P.SC;
    for (int i = vb * NTHR + F.tid; i < 8 * 16384; i += VG * NTHR) {
        const int bh = i >> 14, e = (i & 16383) * 2, h = bh & 3; const float lg = log_gamma_h(h), g128 = __expf(128.f * lg), g127 = __expf(127.f * lg);
        float s0 = 0.f, s1 = 0.f;
#pragma unroll 1
        for (int c0 = 0; c0 < NCH; c0 += 32) { f32x2s kv[32];
#pragma unroll
            for (int j = 0; j < 32; ++j) kv[j] = *(const GAS f32x2s*)(P.KVC + ((size_t)bh * 64 + c0 + j) * 32768 + e);
#pragma unroll
            for (int j = 0; j < 32; ++j) { const size_t o = ((size_t)bh * 64 + c0 + j) * 32768 + e;
                *(GAS unsigned*)(SCT + o) = pk2(s0, s1); s0 = s0 * g128 + g127 * kv[j].x; s1 = s1 * g128 + g127 * kv[j].y; } }
        const int v = e >> 7, d = e & 127; float* pr = P.out + O_PRET + ((size_t)layer * 8 + bh) * 32768;
        pr[(size_t)d * 256 + v] = s0; pr[(size_t)(d + 1) * 256 + v] = s1;
    }
}
constexpr int S0IMG = 128 * KS_;
static_assert(S0IMG + 256 * KS_ <= RING_BYTES && VIMG == S0IMG, "retention output LDS images");
__device__ __forceinline__ void ph_ret_out(const Ctx& F, const Ptrs& P) {
    const bf16* SCT = (const bf16*)P.SC;
    const int lane = F.lane, fr = lane & 15, fq = lane >> 4;
    for (int u = blockIdx.x; u < 512; u += F.G) {
        int w = F.wave; asm volatile("" : "+s"(w));
        const int c = u & 63, h = (u >> 6) & 3, b = u >> 8; const size_t row0 = (size_t)b * T + (size_t)c * RCH;
        const float gam = 1.f - exp2f(-5.f - (float)h);
        const bf16* st = SCT + (size_t)u * 32768;
        __syncthreads();
#pragma unroll
        for (int i = 0; i < 4; ++i) { const int ch = F.tid + i * NTHR, r = ch >> 4, cc = ch & 15;
            const v4u x = *(const GAS v4u*)(P.RK + (row0 + r) * 512 + h * 128 + cc * 8); *(LAS v4u*)(F.lds + KIMG + r * KS_ + cc * 16) = x; }
#pragma unroll
        for (int i = 0; i < 8; ++i) { const int ch = F.tid + i * NTHR, r = ch >> 4, cc = ch & 15;
            const v4u x = *(const GAS v4u*)(st + (size_t)r * 128 + cc * 8); *(LAS v4u*)(F.lds + S0IMG + r * KS_ + cc * 16) = x; }
        v4u vreg[8];
#pragma unroll
        for (int i = 0; i < 8; ++i) { const int ch = F.tid + i * NTHR, r = ch >> 5, cc = ch & 31; vreg[i] = *(const GAS v4u*)(P.RV + (row0 + r) * 1024 + h * 256 + cc * 8); }
        bf16x8 yq[4];
#pragma unroll
        for (int ks = 0; ks < 4; ++ks) yq[ks] = *(const GAS bf16x8*)(P.RQ + (row0 + 16 * w + fr) * 512 + h * 128 + 32 * ks + 8 * fq);
        __syncthreads();
        f32x4 acc[16];
#pragma unroll
        for (int v0 = 0; v0 < 16; v0 += 4) { bf16x8 xs[4][4];
#pragma unroll
            for (int j = 0; j < 4; ++j)
#pragma unroll
                for (int ks = 0; ks < 4; ++ks) xs[j][ks] = *(const LAS bf16x8*)(F.lds + S0IMG + (16 * (v0 + j) + fr) * KS_ + (32 * ks + 8 * fq) * 2);
#pragma unroll
            for (int j = 0; j < 4; ++j) { f32x4 a = (f32x4){0.f, 0.f, 0.f, 0.f};
#pragma unroll
                for (int ks = 0; ks < 4; ++ks) a = mfma16(xs[j][ks], yq[ks], a);
                acc[v0 + j] = a * gam; }
            asm volatile("" ::: "memory"); }
        bf16x8 pf[4];
#pragma unroll
        for (int pp = 0; pp < 4; ++pp) {
            unsigned pk[4] = {0u, 0u, 0u, 0u};
#pragma unroll
            for (int hh = 0; hh < 2; ++hh) { const int jt = 2 * pp + hh;
                if (jt <= w) { f32x4 d4 = (f32x4){0.f, 0.f, 0.f, 0.f};
                    bf16x8 xk[4];
#pragma unroll
                    for (int ks = 0; ks < 4; ++ks) xk[ks] = *(const LAS bf16x8*)(F.lds + KIMG + (16 * jt + fr) * KS_ + (32 * ks + 8 * fq) * 2);
#pragma unroll
                    for (int ks = 0; ks < 4; ++ks) d4 = mfma16(xk[ks], yq[ks], d4);
                    if (jt == w) {
#pragma unroll
                        for (int r = 0; r < 4; ++r) d4[r] = (4 * fq + r <= fr) ? d4[r] : 0.f; }
                    pk[2 * hh] = pk2(d4[0], d4[1]); pk[2 * hh + 1] = pk2(d4[2], d4[3]); } }
            pf[pp] = __builtin_bit_cast(bf16x8, (v4u){pk[0], pk[1], pk[2], pk[3]});
        }
        __syncthreads();
#pragma unroll
        for (int i = 0; i < 8; ++i) { const int ch = F.tid + i * NTHR, r = ch >> 5, cc = ch & 31; *(LAS v4u*)(F.lds + VIMG + r * VS_ + cc * 16) = vreg[i]; }
        __syncthreads();
#pragma unroll
        for (int pp = 0; pp < 4; ++pp) if (2 * pp <= w) {
#pragma unroll
            for (int v0 = 0; v0 < 16; v0 += 8) { bf16x8 xv[8];
#pragma unroll
                for (int j = 0; j < 8; ++j) xv[j] = tr_frag(F.lds + VIMG, VS_, 32 * pp, 32 * pp + 16, 16 * (v0 + j), lane);
#pragma unroll
                for (int j = 0; j < 8; ++j) acc[v0 + j] = mfma16(xv[j], pf[pp], acc[v0 + j]);
                asm volatile("" ::: "memory"); } }
        const size_t ob = (row0 + 16 * w + fr) * 1024 + h * 256 + 4 * fq;
        u32x2v gwv[16];
#pragma unroll
        for (int vt = 0; vt < 16; ++vt) gwv[vt] = *(const GAS u32x2v*)(P.RG + ob + 16 * vt);
        float s1 = 0.f;
#pragma unroll
        for (int vt = 0; vt < 16; ++vt) s1 += (acc[vt][0] + acc[vt][1]) + (acc[vt][2] + acc[vt][3]);
        s1 += __shfl_xor(s1, 16); s1 += __shfl_xor(s1, 32);
        const float mu = s1 * (1.f / 256.f); float s2 = 0.f;
#pragma unroll
        for (int vt = 0; vt < 16; ++vt) { const f32x4 dd = acc[vt] - mu; s2 += (dd[0] * dd[0] + dd[1] * dd[1]) + (dd[2] * dd[2] + dd[3] * dd[3]); }
        s2 += __shfl_xor(s2, 16); s2 += __shfl_xor(s2, 32);
        const float rstd = 1.f / sqrtf(s2 * (1.f / 256.f) + GN_EPS);
#pragma unroll
        for (int vt = 0; vt < 16; ++vt) { const f32x4 o = (acc[vt] - mu) * rstd; u32x2v ww; const u32x2v gw = gwv[vt];
            ww.x = pk2(o[0] * bf2f((bf16)(gw.x & 0xffff)), o[1] * bf2f((bf16)(gw.x >> 16))); ww.y = pk2(o[2] * bf2f((bf16)(gw.y & 0xffff)), o[3] * bf2f((bf16)(gw.y >> 16)));
            *(GAS u32x2v*)(P.RO + ob + 16 * vt) = ww; }
    }
}
__device__ __forceinline__ void ph_ret_sample(const Ctx& F, const Ptrs& P, int layer) {
    LAS float* qk = (LAS float*)(F.lds);
    LAS float* po = (LAS float*)(F.lds + 4096);
    LAS float* red = (LAS float*)(F.lds + 4096 + 8192);
    const int t = F.tid & 255, half = F.tid >> 8, v4 = (t & 63) * 4, dq = t >> 6;
    for (int it0 = blockIdx.x * 2; it0 < NS * RH; it0 += F.G * 2) {
        const int it = it0 + half, n = it >> 2, h = it & 3; const size_t m = (size_t)MPR + n;
        const float gam = 1.f - exp2f(-5.f - (float)h);
        const float* s0 = P.state + (((size_t)layer * NS + n) * RH + h) * 32768 + (size_t)(32 * dq) * 256 + v4;
        float* s1o = P.out + O_SRET + (((size_t)layer * NS + n) * RH + h) * 32768 + (size_t)(32 * dq) * 256 + v4;
        __syncthreads();
        const bf16 qkv = (t < 128) ? P.RK[m * 512 + h * 128 + t] : P.RQ[m * 512 + h * 128 + (t - 128)];
        const u32x2v vw = *(const GAS u32x2v*)(P.RV + m * 1024 + h * 256 + v4);
        f32x4 x[16];
#pragma unroll
        for (int d = 0; d < 16; ++d) x[d] = __builtin_nontemporal_load((const f32x4*)(s0 + (size_t)d * 256));
        qk[half * 256 + t] = bf2f(qkv);
        const f32x4 vv = (f32x4){bf2f((bf16)(vw.x & 0xffff)), bf2f((bf16)(vw.x >> 16)), bf2f((bf16)(vw.y & 0xffff)), bf2f((bf16)(vw.y >> 16))};
        asm volatile("s_waitcnt lgkmcnt(0)" ::: "memory"); __builtin_amdgcn_s_barrier(); asm volatile("" ::: "memory");
        f32x4 o = (f32x4){0.f, 0.f, 0.f, 0.f};
#pragma unroll 1
        for (int d0 = 0; d0 < 32; d0 += 16) {
            if (d0) {
#pragma unroll
                for (int d = 0; d < 16; ++d) x[d] = __builtin_nontemporal_load((const f32x4*)(s0 + (size_t)(d0 + d) * 256)); }
#pragma unroll
            for (int d = 0; d < 16; ++d) { const int dd = 32 * dq + d0 + d; const f32x4 s1 = x[d] * gam + vv * qk[half * 256 + dd]; __builtin_nontemporal_store(s1, (f32x4*)(s1o + (size_t)(d0 + d) * 256)); o += s1 * qk[half * 256 + 128 + dd]; }
        }
        *(LAS f32x4*)(po + (half * 4 + dq) * 256 + v4) = o;
        __syncthreads();
        const float ov = (po[(half * 4 + 0) * 256 + t] + po[(half * 4 + 1) * 256 + t]) + (po[(half * 4 + 2) * 256 + t] + po[(half * 4 + 3) * 256 + t]);
        float s = wave_sum(ov); if ((t & 63) == 0) red[half * 16 + (t >> 6)] = s; __syncthreads();
        const float mu = (red[half * 16 + 0] + red[half * 16 + 1] + red[half * 16 + 2] + red[half * 16 + 3]) * (1.f / 256.f);
        const float dd = ov - mu; float q = wave_sum(dd * dd); if ((t & 63) == 0) red[half * 16 + 4 + (t >> 6)] = q; __syncthreads();
        const float rstd = 1.f / sqrtf((red[half * 16 + 4] + red[half * 16 + 5] + red[half * 16 + 6] + red[half * 16 + 7]) * (1.f / 256.f) + GN_EPS);
        P.RO[m * 1024 + h * 256 + t] = (bf16)f2bf(dd * rstd * bf2f(P.RG[m * 1024 + h * 256 + t]));
    }
}
constexpr float LOG2E = 1.4426950408889634f;
constexpr int AKS_ = 160, AKIMG = 0, AVIMG = 256 * AKS_, AV_ROWS = 272;
static_assert(AVIMG + AV_ROWS * AKS_ <= RING_BYTES, "attention LDS images");
__device__ __forceinline__ float alibi_pen(int g, int h) { return exp2f(-8.f * (float)(g * 4 + h + 1) / 12.f) * (float)(1 << (2 * g)) * LOG2E; }
__device__ __forceinline__ void ph_attn_prompt(const Ctx& F, const Ptrs& P, bf16* OG, float* LSEB) {
    const int lane = F.lane, w = F.wave, fr = lane & 15, fq = lane >> 4, i0 = 16 * w;
    v4u pfk[4], pfv[4]; bf16x8 pfq[2];
#define ATTN_PREFETCH(UN) do { const int un_ = (UN), ub_ = un_ & 63, h_ = (un_ >> 6) & 3, g_ = (un_ >> 8) % 3, b_ = un_ / 768, dsh_ = 2 * g_, dil_ = 1 << dsh_, r_ = ub_ & (dil_ - 1), nb_ = ub_ >> dsh_; \
        const size_t rowb_ = (size_t)b_ * T; const int col_ = g_ * 256 + h_ * 64; \
        _Pragma("unroll") for (int i = 0; i < 4; ++i) { const int ch = F.tid + i * NTHR, kk = ch >> 3, c = ch & 7, l_ = 128 * (nb_ - 1) + kk; unsigned z0 = 0u; asm volatile("" : "+v"(z0)); \
            pfk[i] = (v4u){z0, z0, z0, z0}; pfv[i] = pfk[i]; \
            if (l_ >= 0) { const size_t row = rowb_ + (size_t)l_ * dil_ + r_; pfk[i] = *(const GAS v4u*)(P.AK + row * 768 + col_ + c * 8); pfv[i] = *(const GAS v4u*)(P.AV + row * 768 + col_ + c * 8); } } \
        const size_t qrow_ = rowb_ + (size_t)(128 * nb_ + i0 + fr) * dil_ + r_; \
        _Pragma("unroll") for (int ks = 0; ks < 2; ++ks) pfq[ks] = *(const GAS bf16x8*)(P.AQ + qrow_ * 768 + col_ + 32 * ks + 8 * fq); } while (0)
    if ((int)blockIdx.x < NB * 3 * AH * 64) ATTN_PREFETCH((int)blockIdx.x);
    for (int un = blockIdx.x; un < NB * 3 * AH * 64; un += F.G) {
        const int ub = un & 63, h = (un >> 6) & 3, g = (un >> 8) % 3, b = un / 768;
        const int dsh = 2 * g, dil = 1 << dsh, r = ub & (dil - 1), nb = ub >> dsh;
        const size_t rowb = (size_t)b * T; const int col = g * 256 + h * 64;
        __syncthreads();
#pragma unroll
        for (int i = 0; i < 4; ++i) { const int ch = F.tid + i * NTHR, kk = ch >> 3, c = ch & 7;
            *(LAS v4u*)(F.lds + AKIMG + kk * AKS_ + c * 16) = pfk[i]; *(LAS v4u*)(F.lds + AVIMG + kk * AKS_ + c * 16) = pfv[i]; }
        if (F.tid < 128) { const int kk = 256 + (F.tid >> 3), c = F.tid & 7; unsigned z1 = 0u; asm volatile("" : "+v"(z1)); *(LAS v4u*)(F.lds + AVIMG + kk * AKS_ + c * 16) = (v4u){z1, z1, z1, z1}; }
        const size_t qrow = rowb + (size_t)(128 * nb + i0 + fr) * dil + r;
        bf16x8 yq[2] = {pfq[0], pfq[1]};
        if (un + F.G < NB * 3 * AH * 64) ATTN_PREFETCH(un + F.G);
        const float pen = alibi_pen(g, h);
        asm volatile("s_waitcnt lgkmcnt(0)" ::: "memory"); __builtin_amdgcn_s_barrier(); asm volatile("" ::: "memory");
        f32x4 sc[9]; float mx = -INFINITY;
        bf16x8 xk[9][2];
#pragma unroll
        for (int kt = 0; kt < 9; ++kt)
#pragma unroll
            for (int ks = 0; ks < 2; ++ks) xk[kt][ks] = *(const LAS bf16x8*)(F.lds + AKIMG + (i0 + 16 * kt + fr) * AKS_ + (32 * ks + 8 * fq) * 2);
#pragma unroll
        for (int kt = 0; kt < 9; ++kt) { f32x4 d4 = (f32x4){0.f, 0.f, 0.f, 0.f};
#pragma unroll
            for (int ks = 0; ks < 2; ++ks) d4 = mfma16(xk[kt][ks], yq[ks], d4);
#pragma unroll
            for (int rr = 0; rr < 4; ++rr) { const int dist = fr + 128 - 16 * kt - 4 * fq - rr; const bool ok = dist >= 0 && dist <= 128 && (nb > 0 || i0 + 16 * kt + 4 * fq + rr >= 128);
                d4[rr] = ok ? d4[rr] - pen * (float)dist : -INFINITY; mx = fmaxf(mx, d4[rr]); }
            sc[kt] = d4; }
        mx = fmaxf(mx, __shfl_xor(mx, 16)); mx = fmaxf(mx, __shfl_xor(mx, 32));
        float ls = 0.f; bf16x8 pf[5];
#pragma unroll
        for (int pp = 0; pp < 5; ++pp) { unsigned pk[4] = {0u, 0u, 0u, 0u};
#pragma unroll
            for (int hh = 0; hh < 2; ++hh) { const int kt = 2 * pp + hh;
                if (kt < 9) { f32x4 p4;
#pragma unroll
                    for (int rr = 0; rr < 4; ++rr) { p4[rr] = __builtin_amdgcn_exp2f(sc[kt][rr] - mx); ls += p4[rr]; }
                    pk[2 * hh] = pk2(p4[0], p4[1]); pk[2 * hh + 1] = pk2(p4[2], p4[3]); } }
            pf[pp] = __builtin_bit_cast(bf16x8, (v4u){pk[0], pk[1], pk[2], pk[3]}); }
        ls += __shfl_xor(ls, 16); ls += __shfl_xor(ls, 32);
        f32x4 oa[4];
#pragma unroll
        for (int d0 = 0; d0 < 4; d0 += 2) { bf16x8 xv[2][5];
#pragma unroll
            for (int j = 0; j < 2; ++j)
#pragma unroll
                for (int pp = 0; pp < 5; ++pp) xv[j][pp] = tr_frag(F.lds + AVIMG, AKS_, i0 + 32 * pp, i0 + 32 * pp + 16, 16 * (d0 + j), lane);
#pragma unroll
            for (int j = 0; j < 2; ++j) { f32x4 a = (f32x4){0.f, 0.f, 0.f, 0.f};
#pragma unroll
                for (int pp = 0; pp < 5; ++pp) a = mfma16(xv[j][pp], pf[pp], a);
                oa[d0 + j] = a; } }
        const float inv = 1.f / ls;
        bf16* og = OG + ((size_t)g * MP + qrow) * 256 + h * 64 + 4 * fq;
#pragma unroll
        for (int dt = 0; dt < 4; ++dt) { u32x2v ww; ww.x = pk2(oa[dt][0] * inv, oa[dt][1] * inv); ww.y = pk2(oa[dt][2] * inv, oa[dt][3] * inv); *(GAS u32x2v*)(og + 16 * dt) = ww; }
        if (fq == 0) LSEB[((size_t)g * MP + qrow) * 4 + h] = mx + __builtin_amdgcn_logf(ls);
    }
}
#undef ATTN_PREFETCH
__device__ __forceinline__ void ph_attn_sample(const Ctx& F, const Ptrs& P, bf16* OG, float* LSEB, int layer) {
    const float* const pc0 = P.c0; const float* const pc1 = P.c1; const float* const pc2 = P.c2;
    LAS float* cmb = (LAS float*)F.lds;
    const int lane = F.lane, w = F.wave, hh = lane >> 4, dd = (lane & 15) * 4;
    for (int un = blockIdx.x; un < NS * 3; un += F.G) {
        const int n = un / 3, g = un % 3, dil = 1 << (2 * g), wlen = 128 * dil; const size_t m = (size_t)MPR + n;
        const float* cb = ((g == 0) ? pc0 : (g == 1 ? pc1 : pc2)) + ((size_t)layer * NS + n) * wlen * 512 + hh * 64 + dd;
        const float pen = alibi_pen(g, hh);
        f32x4 q4; { const u32x2v qw = *(const GAS u32x2v*)(P.AQ + m * 768 + g * 256 + hh * 64 + dd); q4 = (f32x4){bf2f((bf16)(qw.x & 0xffff)), bf2f((bf16)(qw.x >> 16)), bf2f((bf16)(qw.y & 0xffff)), bf2f((bf16)(qw.y >> 16))}; }
        float mx = -INFINITY, ls = 0.f; f32x4 o4 = (f32x4){0.f, 0.f, 0.f, 0.f};
        u32x2v kw = (u32x2v){0u, 0u}, vw = kw;
        if (w == 0) { kw = *(const GAS u32x2v*)(P.AK + m * 768 + g * 256 + hh * 64 + dd); vw = *(const GAS u32x2v*)(P.AV + m * 768 + g * 256 + hh * 64 + dd); }
        {
            f32x4 k4[16], v4[16];
#pragma unroll
            for (int jj = 0; jj < 16; ++jj) { const int j = 16 * w + 1 + jj; const float* rp = cb + (size_t)(wlen - dil * j) * 512;
                k4[jj] = __builtin_nontemporal_load((const f32x4*)rp); v4[jj] = __builtin_nontemporal_load((const f32x4*)(rp + 256)); }
#pragma unroll
            for (int jj = 0; jj < 16; ++jj) { const int j = 16 * w + 1 + jj;
                float s = (q4[0] * k4[jj][0] + q4[1] * k4[jj][1]) + (q4[2] * k4[jj][2] + q4[3] * k4[jj][3]);
                s += __shfl_xor(s, 1); s += __shfl_xor(s, 2); s += __shfl_xor(s, 4); s += __shfl_xor(s, 8);
                s -= pen * (float)j;
                const float mn = fmaxf(mx, s), corr = __builtin_amdgcn_exp2f(mx - mn), p = __builtin_amdgcn_exp2f(s - mn);
                ls = ls * corr + p; mx = mn; o4 = o4 * corr + v4[jj] * p; }
        }
        if (w == 0) {
            float s = q4[0] * bf2f((bf16)(kw.x & 0xffff)) + q4[1] * bf2f((bf16)(kw.x >> 16)) + q4[2] * bf2f((bf16)(kw.y & 0xffff)) + q4[3] * bf2f((bf16)(kw.y >> 16));
            s += __shfl_xor(s, 1); s += __shfl_xor(s, 2); s += __shfl_xor(s, 4); s += __shfl_xor(s, 8);
            const float mn = fmaxf(mx, s), corr = __builtin_amdgcn_exp2f(mx - mn), p = __builtin_amdgcn_exp2f(s - mn);
            ls = ls * corr + p; mx = mn;
            o4 = o4 * corr + (f32x4){bf2f((bf16)(vw.x & 0xffff)), bf2f((bf16)(vw.x >> 16)), bf2f((bf16)(vw.y & 0xffff)), bf2f((bf16)(vw.y >> 16))} * p;
        }
        __syncthreads();
        { LAS float* c = cmb + (w * 64 + lane) * 6; c[0] = mx; c[1] = ls; c[2] = o4[0]; c[3] = o4[1]; c[4] = o4[2]; c[5] = o4[3]; }
        __syncthreads();
        if (w == 0) {
            float M = -INFINITY;
#pragma unroll
            for (int ww = 0; ww < 8; ++ww) M = fmaxf(M, cmb[(ww * 64 + lane) * 6]);
            float L = 0.f; f32x4 O = (f32x4){0.f, 0.f, 0.f, 0.f};
#pragma unroll
            for (int ww = 0; ww < 8; ++ww) { const LAS float* c = cmb + (ww * 64 + lane) * 6; const float f = __builtin_amdgcn_exp2f(c[0] - M); L += c[1] * f; O += (f32x4){c[2], c[3], c[4], c[5]} * f; }
            const float inv = 1.f / L;
            u32x2v ww2; ww2.x = pk2(O[0] * inv, O[1] * inv); ww2.y = pk2(O[2] * inv, O[3] * inv);
            *(GAS u32x2v*)(OG + ((size_t)g * MP + m) * 256 + hh * 64 + dd) = ww2;
            if ((lane & 15) == 0) LSEB[((size_t)g * MP + m) * 4 + hh] = M + __builtin_amdgcn_logf(L);
        }
    }
}
__device__ __forceinline__ void ph_attn_merge(const Ctx& F, const Ptrs& P, const bf16* OG, const float* LSEB, int vb, int VG) {
#pragma unroll 4
    for (int i = vb * NTHR + F.tid; i < MR * 32; i += VG * NTHR) {
        const int m = i >> 5, c = i & 31, h = c >> 3;
        const float l0 = LSEB[((size_t)0 * MP + m) * 4 + h], l1 = LSEB[((size_t)1 * MP + m) * 4 + h], l2 = LSEB[((size_t)2 * MP + m) * 4 + h];
        const float M = fmaxf(l0, fmaxf(l1, l2)); float w0 = __builtin_amdgcn_exp2f(l0 - M), w1 = __builtin_amdgcn_exp2f(l1 - M), w2 = __builtin_amdgcn_exp2f(l2 - M);
        const float inv = 1.f / (w0 + w1 + w2); w0 *= inv; w1 *= inv; w2 *= inv;
        const v4u a = *(const GAS v4u*)(OG + ((size_t)0 * MP + m) * 256 + c * 8), bq = *(const GAS v4u*)(OG + ((size_t)1 * MP + m) * 256 + c * 8), cq = *(const GAS v4u*)(OG + ((size_t)2 * MP + m) * 256 + c * 8);
        v4u o;
#pragma unroll
        for (int j = 0; j < 4; ++j) { const unsigned x = a[j], y = bq[j], z = cq[j];
            const float lo = w0 * bf2f((bf16)(x & 0xffff)) + w1 * bf2f((bf16)(y & 0xffff)) + w2 * bf2f((bf16)(z & 0xffff));
            const float hi = w0 * bf2f((bf16)(x >> 16)) + w1 * bf2f((bf16)(y >> 16)) + w2 * bf2f((bf16)(z >> 16));
            o[j] = pk2(lo, hi); }
        *(GAS v4u*)(P.AO + (size_t)m * 256 + c * 8) = o;
    }
}

template <int NT, int NC, int MT, int KB, class Epi>
__device__ __forceinline__ void small_gemm_r(const Ctx& F, const bf16* A, const bf16* Bt, int N, int K, const Epi& E, int vb, int nbk, int it0, int it1);
template <int NT, int NC, int MT, int KB, class Epi>
__device__ __forceinline__ void small_gemm(const Ctx& F, const bf16* A, const bf16* Bt, int N, int K, const Epi& E, int first_block = 0) {
    const int nitems = ((NT == 1) ? N / (16 * NC) : N / 32) * (8 / MT);
    small_gemm_r<NT, NC, MT, KB, Epi>(F, A, Bt, N, K, E, (int)blockIdx.x - first_block, (int)gridDim.x - first_block, 0, nitems);
}
template <int NT, int NC, int MT, int KB, class Epi>
__device__ __forceinline__ void small_gemm_r(const Ctx& F, const bf16* A, const bf16* Bt, int N, int K, const Epi& E, int vb, int nbk, int it0, int it1) {
    LAS f32x4* red = (LAS f32x4*)F.lds;
    const int lane = F.lane, w = F.wave, fr = lane & 15, fq = lane >> 4;
    constexpr int RP = 8 / MT;
    const int ksw = K / 32 / (8 / NT), kw = (NT == 1) ? w : (w & 3);
    if (vb < 0 || vb >= nbk) return;
    for (int it = it0 + nbk - 1 - vb; it < it1; it += nbk) {
        const int ct = it / RP, rh = it % RP;
        int brow;
        if (NT == 1) brow = 16 * NC * ct; else { const int j0 = 16 * ct; brow = 256 * (j0 >> 7) + (j0 & 127) + ((w >> 2) ? 128 : 0); }
        f32x4 acc[NC][MT];
#pragma unroll
        for (int c = 0; c < NC; ++c)
#pragma unroll
            for (int mt = 0; mt < MT; ++mt) acc[c][mt] = (f32x4){0.f, 0.f, 0.f, 0.f};
        const bf16* bp = Bt + (size_t)(brow + fr) * K + 8 * fq + 32 * (kw * ksw); const bf16* ap = A + (size_t)(16 * MT * rh + fr) * K + 8 * fq + 32 * (kw * ksw);
#pragma unroll 1
        for (int k0 = 0; k0 < ksw; k0 += KB) {
            bf16x8 yb[KB][NC], xa[KB][MT];
#pragma unroll
            for (int j = 0; j < KB; ++j) if (k0 + j < ksw) {
#pragma unroll
                for (int c = 0; c < NC; ++c) yb[j][c] = *(const GAS bf16x8*)(bp + (size_t)(16 * c) * K + 32 * (k0 + j));
#pragma unroll
                for (int mt = 0; mt < MT; ++mt) xa[j][mt] = *(const GAS bf16x8*)(ap + (size_t)(16 * mt) * K + 32 * (k0 + j)); }
#pragma unroll
            for (int j = 0; j < KB; ++j) if (k0 + j < ksw) {
#pragma unroll
                for (int c = 0; c < NC; ++c)
#pragma unroll
                    for (int mt = 0; mt < MT; ++mt) acc[c][mt] = mfma16(yb[j][c], xa[j][mt], acc[c][mt]); }
        }
        __syncthreads();
#pragma unroll
        for (int c = 0; c < NC; ++c)
#pragma unroll
            for (int mt = 0; mt < MT; ++mt) red[((w * NC + c) * MT + mt) * 64 + lane] = acc[c][mt];
        __syncthreads();
        if (w < MT) {
            if constexpr (NT == 1) {
#pragma unroll
                for (int c = 0; c < NC; ++c) { f32x4 v = red[((0 * NC + c) * MT + w) * 64 + lane];
#pragma unroll
                    for (int ww = 1; ww < 8; ++ww) v += red[((ww * NC + c) * MT + w) * 64 + lane];
                    E.small(16 * MT * rh + 16 * w + fr, 16 * (NC * ct + c) + 4 * fq, v); }
            } else { f32x4 g = red[(0 * MT + w) * 64 + lane], up = red[(4 * MT + w) * 64 + lane];
#pragma unroll
                for (int ww = 1; ww < 4; ++ww) { g += red[(ww * MT + w) * 64 + lane]; up += red[((4 + ww) * MT + w) * 64 + lane]; }
                E.small2(16 * MT * rh + 16 * w + fr, 16 * ct + 4 * fq, g, up);
            }
        }
    }
}
__device__ __forceinline__ int stage_rs(LAS unsigned char* L, const float* ssp, int wave0, int tail_pm = -1) {
    if ((int)gridDim.x != 256) return -1;
    const int row0 = 2048 * ((int)blockIdx.x & 7), t = wave0 * 64 + lane_id();
    LAS float* tab = (LAS float*)(L + pg8::RS_LDS_OFF);
#pragma unroll
    for (int i = 0; i < 4; ++i) tab[t + i * NTHR] = __builtin_amdgcn_rsqf(ssp[row0 + t + i * NTHR] * (1.f / DM) + RMS_EPS);
    if (tail_pm >= 0 && t < 256) tab[pg8::RS_LDS_ROWS + t] = __builtin_amdgcn_rsqf(ssp[tail_pm * 256 + t] * (1.f / DM) + RMS_EPS);
    __syncthreads();
    return row0;
}
#ifndef SKIP
#define SKIP 0
#endif
#define ON(b) (!((SKIP >> (b)) & 1))
#ifndef REPM
#define REPM 0
#endif
#ifndef REPX
#define REPX 2
#endif
#define NREP(b) (1 + (((REPM) >> (b)) & 1) * (REPX))
#ifndef MREP
#define MREP 0
#endif
#define MR_(b) for (int mr_ = 0; mr_ < 1 + ((MREP >> (b)) & 1) * 2; ++mr_)
#ifndef SREP
#define SREP 0
#endif
#define REPEAT(b) for (int rep_ = 0; rep_ < NREP(b); ++rep_)
#define REPBAR(b) do { if (rep_ + 1 < NREP(b)) xcd_barrier(bar); } while (0)
constexpr int PH_PER_LAYER = 9, N_PHASES = 2 + DEPTH * PH_PER_LAYER;
__global__ void __launch_bounds__(NTHR, 2) fwd(Args args) {
    extern __shared__ __attribute__((aligned(16))) unsigned char lds[];
    LAS unsigned char* const L = (LAS unsigned char*)lds;
    const int wave0 = __builtin_amdgcn_readfirstlane((int)(threadIdx.x >> 6));
    for (int u = threadIdx.x; u < (LDS_BYTES - LDSCTL_OFF) / 4; u += NTHR) ((LAS unsigned*)(L + LDSCTL_OFF))[u] = 0u;
    __syncthreads();
    gu32* ctl = (gu32*)(args.ws + WS_CTL);
    XcdBarrier bar = xcd_barrier_post((unsigned*)(ctl + CW_BAR), (volatile LAS unsigned*)(L + MISC_OFF) + 8);
    const int lo = args.ph_lo, hi = args.ph_hi;
#define IN(k) (lo <= (k) && (k) < hi)
#define SEAM(k) do { if (IN(k) && IN((k) + 1)) xcd_barrier(bar); } while (0)
    REPEAT(0) { if (IN(0) && ON(0)) { const Ptrs P = late_ptrs(); const Ctx F = make_ctx(L, wave0); ph_prologue(F, P); } REPBAR(0); } SEAM(0);
    for (int l = 0; l < DEPTH; ++l) {
        const int pb = 1 + l * PH_PER_LAYER;
        REPEAT(1) { if (IN(pb + 0) && ON(1)) {
            const Ptrs P = late_ptrs(); unsigned char* wl = P.ws + WS_W + (size_t)l * W_LAYER; const bf16* XB = (const bf16*)(P.ws + WS_XB);
            pg8::Gemm g{XB, (const bf16*)(wl + W_IN), MPR, DIN, DM};
            int gd_ = (int)gridDim.x, cb = (int)blockIdx.x; asm volatile("" : "+s"(gd_), "+s"(cb));     const bool g256 = gd_ == 256; const bool odd = cb & 1;
            int tpm; { pg8::StaticOrder S0; S0.init(MPR, DIN, gd_, cb, 0, g256 ? 1 : 0); tpm = S0.tail_pm(); }
            const float* ssp = (const float*)(P.ws + WS_SSP) + (size_t)(2 * l) * MPR; const int rs0 = stage_rs(L, ssp, wave0, tpm);
            pg8::EpiProj E{P.ws, P.out, l, ssp, (const float*)(P.ws + WS_SSS) + (2 * l) * NS, rs0};
            if (g256) { if (odd) small_gemm_r<1, 2, 4, 4>(make_ctx(L, wave0), XB + (size_t)MPR * DM, (const bf16*)(wl + W_IN), DIN, DM, E, cb >> 1, 128, 0, 256); __syncthreads(); }
            pg8::StaticOrder S; S.init(MPR, DIN, gd_, cb, 0, g256 ? 1 : 0);
            pg8::gemm_phase<pg8::EpiProj, pg8::StaticOrder, true, true>(L, g, S, E, wave0);
            if (g256) { if (!odd && cb >= 128) small_gemm_r<1, 2, 4, 4>(make_ctx(L, wave0), XB + (size_t)MPR * DM, (const bf16*)(wl + W_IN), DIN, DM, E, (cb - 128) >> 1, 64, 256, (DIN / 32) * 2); }
            else small_gemm<1, 2, 4, 4>(make_ctx(L, wave0), XB + (size_t)MPR * DM, (const bf16*)(wl + W_IN), DIN, DM, E, 0);
            __syncthreads();
            if (l == 0 && (g256 ? odd : cb >= 64)) { const Ctx F = make_ctx(L, wave0);
                if (g256) convert_weights(F, P, I_IN, DEPTH * I_LAYER, (cb >> 1) * NWAVES + F.wave, 128 * NWAVES); else convert_weights(F, P, I_IN, DEPTH * I_LAYER, (cb - 64) * NWAVES + F.wave, ((int)gridDim.x - 64) * NWAVES); }
        } REPBAR(1); } SEAM(pb + 0);
        REPEAT(2) { if (IN(pb + 1)) { const Ptrs P = late_ptrs(); bf16* OG = (bf16*)(P.ws + WS_OG); float* LSEB = (float*)(P.ws + WS_LSE);
#pragma unroll 1
            for (int pass = 0; pass < 2; ++pass) {
                if (((pass ^ (int)blockIdx.x) & 1) == 0) { MR_(0) { ph_ret_sample(make_ctx(L, wave0), P, l); __syncthreads(); } MR_(1) { ph_attn_sample(make_ctx(L, wave0), P, OG, LSEB, l); __syncthreads(); } }
                else { MR_(2) { ph_ret_kv(make_ctx(L, wave0), P); __syncthreads(); } MR_(3) { ph_attn_prompt(make_ctx(L, wave0), P, OG, LSEB); __syncthreads(); } }
                __syncthreads(); }
        } REPBAR(2); } SEAM(pb + 1);
        REPEAT(5) { if (IN(pb + 2) && ON(5)) { const Ptrs P = late_ptrs(); const Ctx F = make_ctx(L, wave0); ph_ret_scan(F, P, l, (int)blockIdx.x, (int)gridDim.x); ph_attn_merge(F, P, (const bf16*)(P.ws + WS_OG), (const float*)(P.ws + WS_LSE), (int)blockIdx.x, (int)gridDim.x); } REPBAR(5); } SEAM(pb + 2);
        REPEAT(6) { if (IN(pb + 3) && ON(6)) { const Ptrs P = late_ptrs(); const Ctx F = make_ctx(L, wave0); ph_ret_out(F, P); __syncthreads(); } REPBAR(6); }
        REPEAT(7) { if (IN(pb + 4) && ON(7)) {
            const Ptrs P = late_ptrs(); unsigned char* wl = P.ws + WS_W + (size_t)l * W_LAYER;
            pg8::Gemm g{P.AO, (const bf16*)(wl + W_ATT), MPR, DM, 256}; pg8::StaticOrder S; S.init(MPR, DM, (int)gridDim.x, (int)blockIdx.x);
            pg8::EpiAbr E{P.ws};
            pg8::gemm_phase<pg8::EpiAbr, pg8::StaticOrder, true, true>(L, g, S, E, wave0);
            for (int sr_ = 0; sr_ <= SREP; ++sr_) { small_gemm<1, 1, 2, 1>(make_ctx(L, wave0), P.AO + (size_t)MPR * 256, (const bf16*)(wl + W_ATT), DM, 256, E); __syncthreads(); }
        } REPBAR(7); } SEAM(pb + 4);
        REPEAT(8) { if (IN(pb + 5) && ON(8)) {
            const Ptrs P = late_ptrs(); unsigned char* wl = P.ws + WS_W + (size_t)l * W_LAYER;
            pg8::Gemm g{P.RO, (const bf16*)(wl + W_RET), MPR, DM, DM}; pg8::StaticOrder S; S.init(MPR, DM, (int)gridDim.x, (int)blockIdx.x);
            pg8::EpiRbr E{P.ws};
            pg8::gemm_phase<pg8::EpiRbr, pg8::StaticOrder, true, true>(L, g, S, E, wave0);
            for (int sr_ = 0; sr_ <= SREP; ++sr_) { small_gemm<1, 1, 2, 4>(make_ctx(L, wave0), P.RO + (size_t)MPR * DM, (const bf16*)(wl + W_RET), DM, DM, E); __syncthreads(); }
        } REPBAR(8); } SEAM(pb + 5);
        if (IN(pb + 6) && ON(9)) {
            const Ptrs P = late_ptrs(); unsigned char* wl = P.ws + WS_W + (size_t)l * W_LAYER;
            pg8::Gemm g{P.MG, (const bf16*)(wl + W_OUT), MPR, DM, DM}; pg8::StaticOrder S; S.init(MPR, DM, (int)gridDim.x, (int)blockIdx.x);
            pg8::EpiResid E{(bf16*)(P.ws + WS_XB), (float*)(P.ws + WS_SSP) + (size_t)(2 * l + 1) * MPR, (float*)(P.ws + WS_SSS) + (2 * l + 1) * NS};
            pg8::gemm_phase<pg8::EpiResid, pg8::StaticOrder, true, true>(L, g, S, E, wave0);
            small_gemm<1, 1, 2, 4>(make_ctx(L, wave0), P.MG + (size_t)MPR * DM, (const bf16*)(wl + W_OUT), DM, DM, E);
        } SEAM(pb + 6);
        REPEAT(11) { if (IN(pb + 7) && ON(11)) {
            const Ptrs P = late_ptrs(); unsigned char* wl = P.ws + WS_W + (size_t)l * W_LAYER; const bf16* XB = (const bf16*)(P.ws + WS_XB);
            pg8::Gemm g{XB, (const bf16*)(wl + W_GU), MPR, 2 * DFF, DM};
            int gd_ = (int)gridDim.x, cb = (int)blockIdx.x; asm volatile("" : "+s"(gd_), "+s"(cb));     const bool g256 = gd_ == 256; const bool odd = cb & 1;
            int tpm; { pg8::StaticOrder S0; S0.init(MPR, 2 * DFF, gd_, cb, 0, g256 ? 1 : 0); tpm = S0.tail_pm(); }
            const float* ssp = (const float*)(P.ws + WS_SSP) + (size_t)(2 * l + 1) * MPR; const int rs0 = stage_rs(L, ssp, wave0, tpm);
            pg8::EpiSwiglu E{P.H, ssp, (const float*)(P.ws + WS_SSS) + (2 * l + 1) * NS, rs0};
            if (g256) { if (odd) small_gemm_r<2, 1, 4, 4>(make_ctx(L, wave0), XB + (size_t)MPR * DM, (const bf16*)(wl + W_GU), 2 * DFF, DM, E, cb >> 1, 128, 0, 256); __syncthreads(); }
            pg8::StaticOrder S; S.init(MPR, 2 * DFF, gd_, cb, 0, g256 ? 1 : 0);
            pg8::gemm_phase<pg8::EpiSwiglu, pg8::StaticOrder, true, true>(L, g, S, E, wave0);
            if (g256) { if (odd) small_gemm_r<2, 1, 4, 4>(make_ctx(L, wave0), XB + (size_t)MPR * DM, (const bf16*)(wl + W_GU), 2 * DFF, DM, E, cb >> 1, 128, 256, (2 * DFF / 32) * 2); }
            else small_gemm<2, 1, 4, 4>(make_ctx(L, wave0), XB + (size_t)MPR * DM, (const bf16*)(wl + W_GU), 2 * DFF, DM, E, 0);
            __syncthreads();
        } REPBAR(11); } SEAM(pb + 7);
        if (IN(pb + 8) && ON(12)) {
            const Ptrs P = late_ptrs(); unsigned char* wl = P.ws + WS_W + (size_t)l * W_LAYER;
            pg8::Gemm g{P.H, (const bf16*)(wl + W_DN), MPR, DM, DFF}; pg8::StaticOrder S; S.init(MPR, DM, (int)gridDim.x, (int)blockIdx.x);
            pg8::EpiResid E{(bf16*)(P.ws + WS_XB), (float*)(P.ws + WS_SSP) + (size_t)(2 * l + 2) * MPR, (float*)(P.ws + WS_SSS) + (2 * l + 2) * NS};
            int gdn_ = (int)gridDim.x; asm volatile("" : "+s"(gdn_));
            if (l == DEPTH - 1 && gdn_ == 256) {
                pg8::EpiResidFinal EF{(const bf16*)(P.ws + WS_XB), (float*)(P.ws + WS_SSP) + (size_t)(2 * l + 2) * MPR, P.out + O_YP, P.norm_final, (unsigned*)(P.ws + WS_CTL) + CW_PAN, (unsigned*)(P.ws + WS_CTL) + CW_BAR + XB_TMO};
                pg8::gemm_phase<pg8::EpiResidFinal, pg8::StaticOrder, true, true>(L, g, S, EF, wave0);
            } else pg8::gemm_phase<pg8::EpiResid, pg8::StaticOrder, true, true>(L, g, S, E, wave0);
            small_gemm<1, 1, 2, 11>(make_ctx(L, wave0), P.H + (size_t)MPR * DFF, (const bf16*)(wl + W_DN), DM, DFF, E);
        } SEAM(pb + 8);
    }
    REPEAT(13) { if (IN(N_PHASES - 1) && ON(13)) { const Ptrs P = late_ptrs(); const Ctx F = make_ctx(L, wave0); ph_final_norm(F, P, ((int)gridDim.x == 256) ? MPR : 0); } REPBAR(13); }
#undef IN
#undef SEAM
}

#ifndef N_CUTS
#define N_CUTS 0
#endif
extern "C" void kernel_launch(void* const* d_in, const int* in_sizes, int n_in, void* d_out, int out_size, void* d_ws, size_t ws_size, hipStream_t stream) {
    static int grid = 0;
    if (grid == 0) {
        if (n_in != 15 || out_size != (int)O_END || ws_size < WS_END) { fprintf(stderr, "kernel_launch: unexpected shapes n_in %d out %d ws %zu (need %zu)\n", n_in, out_size, ws_size, (size_t)WS_END); grid = -1; return; }
        int dev = 0, cus = 0, per_cu = 0;
        if (hipGetDevice(&dev) != hipSuccess || hipDeviceGetAttribute(&cus, hipDeviceAttributeMultiprocessorCount, dev) != hipSuccess) { grid = -1; return; }
        if (hipFuncSetAttribute((const void*)fwd, hipFuncAttributeMaxDynamicSharedMemorySize, LDS_BYTES) != hipSuccess) { fprintf(stderr, "kernel_launch: hipFuncSetAttribute failed\n"); grid = -1; return; }
        if (hipOccupancyMaxActiveBlocksPerMultiprocessor(&per_cu, (const void*)fwd, NTHR, LDS_BYTES) != hipSuccess || per_cu < 1) fprintf(stderr, "kernel_launch: occupancy query says %d\n", per_cu);
        (void)hipGetLastError();
        grid = cus;
    }
    if (grid < 0) return;
    (void)hipMemsetAsync((char*)d_ws + WS_CTL, 0, CTL_ZERO_BYTES, stream);
    Args a{};
    for (int i = 0; i < 15; ++i) a.in[i] = (const float*)d_in[i];
    a.out = (float*)d_out; a.ws = (unsigned char*)d_ws;
#if N_CUTS == 0
    a.ph_lo = 0; a.ph_hi = N_PHASES;
    hipLaunchKernelGGL(fwd, dim3(grid), dim3(NTHR), LDS_BYTES, stream, a);
#else
    for (int p = 0; p < N_PHASES; ++p) { a.ph_lo = p; a.ph_hi = p + 1; hipLaunchKernelGGL(fwd, dim3(grid), dim3(NTHR), LDS_BYTES, stream, a); }
#endif
}
```

```cpp
#include <hip/hip_runtime.h>
#include <cstdio>
#include <cstdint>
__device__ __forceinline__ int lane_id() { int l; asm volatile("v_mbcnt_lo_u32_b32 %0, -1, 0\n\tv_mbcnt_hi_u32_b32 %0, -1, %0" : "=&v"(l)); return l; }
constexpr int DM = 1024, NB = 2, T = 8192, DEPTH = 2, NS = 128, PAST = 2048;
constexpr int MPR = NB * T;
constexpr int MR = MPR + NS;
constexpr int MP = 16640;
constexpr int RH = 4, RCH = 128, NCH = T / RCH;
constexpr int AH = 4;
constexpr int DFF = 2816, DIN = 7424;
constexpr float RMS_EPS = 1e-6f, GN_EPS = 1e-5f;
constexpr size_t O_YP = 0;
constexpr size_t O_YS = O_YP + (size_t)NB * T * DM;
constexpr size_t O_PRET = O_YS + (size_t)NS * DM;
constexpr size_t O_PKV0 = O_PRET + (size_t)DEPTH * NB * RH * 128 * 256;
constexpr size_t O_PKV1 = O_PKV0 + (size_t)DEPTH * NB * 128 * 512;
constexpr size_t O_PKV2 = O_PKV1 + (size_t)DEPTH * NB * 512 * 512;
constexpr size_t O_SRET = O_PKV2 + (size_t)DEPTH * NB * 2048 * 512;
constexpr size_t O_SKV0 = O_SRET + (size_t)DEPTH * NS * RH * 128 * 256;
constexpr size_t O_SKV1 = O_SKV0 + (size_t)DEPTH * NS * 512;
constexpr size_t O_SKV2 = O_SKV1 + (size_t)DEPTH * NS * 512;
constexpr size_t O_END = O_SKV2 + (size_t)DEPTH * NS * 512;
static_assert(O_END == 56885248, "output size");
constexpr size_t MiB = 1u << 20;
constexpr size_t al(size_t x) { return (x + MiB - 1) / MiB * MiB; }
constexpr size_t WS_CTL = 0, CTL_ZERO_BYTES = 32768;
constexpr size_t WS_XF = 1 * MiB;
constexpr size_t WS_HN = WS_XF + al((size_t)MP * DM * 4);
constexpr size_t WS_RQ = WS_HN + al((size_t)MP * DM * 2);
constexpr size_t WS_RK = WS_RQ + al((size_t)MP * 512 * 2);
constexpr size_t WS_RV = WS_RK + al((size_t)MP * 512 * 2);
constexpr size_t WS_RG = WS_RV + al((size_t)MP * 1024 * 2);
constexpr size_t WS_AQ = WS_RG + al((size_t)MP * 1024 * 2);
constexpr size_t WS_AK = WS_AQ + al((size_t)MP * 768 * 2);
constexpr size_t WS_AV = WS_AK + al((size_t)MP * 768 * 2);
constexpr size_t WS_GR = WS_AV + al((size_t)MP * 768 * 2);
constexpr size_t WS_GA = WS_GR + al((size_t)MP * 1024 * 2);
constexpr size_t WS_KVC = WS_GA + al((size_t)MP * 1024 * 2);
constexpr size_t WS_SC = WS_KVC + al((size_t)512 * 32768 * 4);
constexpr size_t WS_RO = WS_SC + al((size_t)512 * 32768 * 4);
constexpr size_t WS_AO = WS_RO + al((size_t)MP * 1024 * 2);
constexpr size_t WS_ABR = WS_AO + al((size_t)MP * 256 * 2);
constexpr size_t WS_MG = WS_ABR + al((size_t)MP * 1024 * 4);
constexpr size_t WS_H = WS_MG + al((size_t)MP * 1024 * 2);
constexpr size_t WS_OG = WS_H + al((size_t)MP * DFF * 2);
constexpr size_t WS_LSE = WS_OG + al((size_t)3 * MP * 256 * 2);
constexpr size_t WS_XB = WS_LSE + al((size_t)3 * MP * 4 * 4);
constexpr size_t WS_SSP = WS_XB + al((size_t)MP * DM * 2);
constexpr size_t WS_SSS = WS_SSP + al((size_t)5 * MPR * 16 * 4);
constexpr size_t WS_W = WS_SSS + al((size_t)5 * NS * 4);
constexpr size_t W_IN = 0, W_RET = W_IN + (size_t)DIN * DM * 2, W_ATT = W_RET + (size_t)DM * DM * 2, W_OUT = W_ATT + (size_t)DM * 256 * 2,
                 W_GU = W_OUT + (size_t)DM * DM * 2, W_DN = W_GU + (size_t)2 * DFF * DM * 2, W_LAYER = al(W_DN + (size_t)DM * DFF * 2);
constexpr size_t WS_END = WS_W + DEPTH * W_LAYER;
constexpr int CW_TMO = 0, CW_BAR = 4096;
constexpr int RING_BYTES = 131072, LDSCTL_OFF = RING_BYTES, MISC_OFF = LDSCTL_OFF + 320, LDS_BYTES = 147456;
constexpr int NWAVES = 8, NTHR = 512;
namespace pg8 {
#define PG8_LAS __attribute__((address_space(3)))
typedef unsigned short bf16_t;
typedef short bf16x8 __attribute__((ext_vector_type(8)));
typedef float f32x4 __attribute__((ext_vector_type(4)));
typedef unsigned u32x4 __attribute__((ext_vector_type(4)));
constexpr int BM = 256, BK = 64, HALF = 128, HTB = HALF * BK * 2  , STAGE_BYTES = 8 * HTB, NXCD = 8, WGM = 4;

__host__ __device__ __forceinline__ int lds_byte(int r, int c) { const int st = (r >> 4) * 2 + (c >> 5), rr = r & 15, cc = c & 31, ob = rr * 64 + cc * 2; return st * 1024 + (ob ^ (((ob >> 9) & 1) << 5)); }
__host__ __device__ __forceinline__ void stage_rc(int b, int& R, int& C) { const int st = b / 1024, sb = b % 1024, swz = sb ^ (((sb >> 9) & 1) << 5); R = (st >> 1) * 16 + swz / 64; C = (st & 1) * 32 + (swz % 64) / 2; }
__host__ __device__ __forceinline__ int perm32(int rho) { const int n = rho >> 4, i = rho & 15; return 8 * (i >> 2) + 4 * n + (i & 3); }

struct Unit { int pm, pn, half; };
struct Gemm { const bf16_t* A; const bf16_t* Bt; int M, N, K; };

struct StaticOrder {
    int nM, nN, nwg, G, c;
    __host__ __device__ void init(int M, int N, int G_, int c_, int split_ = 0, int tail_even_ = 0) { nM = M / BM; nN = N / BM; nwg = nM * nN; G = G_; c = c_; split = split_; tail_even = tail_even_; }
    __host__ __device__ __attribute__((always_inline)) int tail_pm() const { Unit u; return next(nwg / G, u) ? u.pm : -1; }
    int tail_even;
    int split;
    __host__ __device__ __attribute__((always_inline)) bool next(int i, Unit& u) const {
        const int nfull = nwg / G, rem = nwg % G; long L; u.half = -1;
        if (i < nfull) L = (long)i * G + c;
        else if (i == nfull && split && rem > 0 && 2 * rem <= G) { if (c >= 2 * rem) return false; L = (long)nfull * G + (c >> 1); u.half = c & 1; }
        else if (i == nfull && tail_even) { if ((c & 1) || (c >> 1) >= rem) return false; L = (long)nfull * G + (c >> 1); }
        else { L = (long)i * G + c; if (L >= nwg) return false; }
        int wgid = (int)L; { const int q = nwg / NXCD, r = nwg % NXCD, xcd = wgid % NXCD, off = wgid / NXCD; wgid = (xcd < r ? xcd * (q + 1) : r * (q + 1) + (xcd - r) * q) + off; }
        const int nig = WGM * nN, gid = wgid / nig, fm = gid * WGM, gsz = (nM - fm) < WGM ? (nM - fm) : WGM;
        u.pm = fm + ((wgid % nig) % gsz); u.pn = (wgid % nig) / gsz; return true;
    }
    __device__ __forceinline__ void a_ready(const Unit&) const {}
    __device__ __forceinline__ void done(const Unit&) const {}
};
struct ColTileOrder { int pm, pn; __host__ __device__ bool next(int i, Unit& u) const { if (i != 0) return false; u.pm = pm; u.pn = pn; u.half = -1; return true; }
    __device__ __forceinline__ void a_ready(const Unit&) const {} __device__ __forceinline__ void done(const Unit&) const {} };
typedef float f32x2_t __attribute__((ext_vector_type(2))); typedef __bf16 bf16x2_t __attribute__((ext_vector_type(2)));
__device__ __forceinline__ unsigned cvt_pk_bf16(float lo, float hi) { f32x2_t v = {lo, hi}; bf16x2_t b = __builtin_convertvector(v, bf16x2_t); return __builtin_bit_cast(unsigned, b); }
typedef float f32x2 __attribute__((ext_vector_type(2)));
typedef unsigned u32x2 __attribute__((ext_vector_type(2)));
__device__ __forceinline__ float bf_lo(unsigned w) { return __builtin_bit_cast(float, w << 16); }
__device__ __forceinline__ float bf_hi(unsigned w) { return __builtin_bit_cast(float, w & 0xffff0000u); }
__device__ __forceinline__ float fast_sigmoid(float x) { return __builtin_amdgcn_rcpf(1.f + __expf(-x)); }
constexpr int RS_LDS_OFF = 131072 + 1024, RS_LDS_ROWS = 2048;
__device__ __forceinline__ float rs_tab(int row_rel) { return ((const PG8_LAS float*)(size_t)RS_LDS_OFF)[row_rel]; }
__device__ __forceinline__ float row_rs(const float* ssp, int row) { return __builtin_amdgcn_rsqf(ssp[row] * (1.f / DM) + RMS_EPS); }
__device__ __forceinline__ float row_rs_s(const float* sss, int n) { return __builtin_amdgcn_rsqf(sss[n] * (1.f / DM) + RMS_EPS); }
struct EpiProj {
    static constexpr bool PERM = true, AFTER_DRAIN = false, ADJ = true;
    unsigned char* ws; float* out; int layer; const float* ssp; const float* sss; int rs_row0;
    static __device__ __forceinline__ unsigned xor8(unsigned x) { return (unsigned)__builtin_amdgcn_update_dpp(0, (int)x, 0x128, 0xf, 0xf, false); }
    template <int MODE>
    __device__ __forceinline__ void body(const f32x4 (&acc)[2][2][4][2], const Unit& u, int wr, int wc, int fr, int fq, bf16_t* base, int ldc, int colt, float sc, int g, int kvsel) const {
        const int rloc = wr * 64 + fr, cloc = wc * 64 + 8 * fq;
        const int nai = u.half < 0 ? 2 : 1, roff = u.half > 0 ? HALF : 0;
        const bool lo = fr < 8;
        const int tb = ((unsigned)(u.pm * BM - rs_row0) < (unsigned)RS_LDS_ROWS) ? u.pm * BM - rs_row0 : RS_LDS_ROWS;
        float rsv[2][4];
#pragma unroll
        for (int ai = 0; ai < 2; ++ai)
#pragma unroll
            for (int m = 0; m < 4; ++m) { const int row = u.pm * BM + roff + ai * HALF + m * 16 + rloc; rsv[ai][m] = (ai < nai) ? (rs_row0 >= 0 ? rs_tab(row - u.pm * BM + tb) : row_rs(ssp, row)) : 0.f; }
#pragma unroll
        for (int ai = 0; ai < 2; ++ai) if (ai < nai)
#pragma unroll
            for (int m = 0; m < 4; ++m) {
                const int rt = roff + ai * HALF + m * 16 + rloc;
                const float rs = rsv[ai][m];
                u32x4 w[2];
#pragma unroll
                for (int bj = 0; bj < 2; ++bj) {
                    f32x4 v0 = acc[ai][bj][m][0] * rs, v1 = acc[ai][bj][m][1] * rs;
                    if (MODE == 3) {
                        const int keep = 128 << (2 * g); const int hd = bj * 32 + cloc; float* dst = nullptr;
                        if (u.pm < 64) { const int b = u.pm >> 5, t = (u.pm & 31) * 256 + rt;
                            if (t >= T - keep) dst = out + (g == 0 ? O_PKV0 : (g == 1 ? O_PKV1 : O_PKV2)) + ((((size_t)layer * NB + b) * keep + (t - (T - keep))) * 2 + kvsel) * 256 + hd; }
                        else if (rt < NS) dst = out + (g == 0 ? O_SKV0 : (g == 1 ? O_SKV1 : O_SKV2)) + (((size_t)layer * NS + rt) * 2 + kvsel) * 256 + hd;
                        if (dst) { *(f32x4*)dst = v0; *(f32x4*)(dst + 4) = v1; }
                    } else if (MODE == 1) {
#pragma unroll
                        for (int j = 0; j < 4; ++j) { v0[j] = v0[j] * fast_sigmoid(v0[j]); v1[j] = v1[j] * fast_sigmoid(v1[j]); }
                    } else if (MODE == 2) {
#pragma unroll
                        for (int j = 0; j < 4; ++j) { v0[j] = fast_sigmoid(v0[j]); v1[j] = fast_sigmoid(v1[j]); }
                    } else if (MODE == 4) {
                        const int hh = g + (wc >> 1);
                        const float lg2 = (hh == 0) ? -0.045803689613124f : (hh == 1 ? -0.022720076500083f : (hh == 2 ? -0.011315313227834f : -0.005646563141142f));
                        const float ii = (u.pm < 64) ? (float)(m * 16 + rloc) : 0.f;
                        const float f = sc * __builtin_amdgcn_exp2f((kvsel ? -ii : ii) * lg2);
                        v0 = v0 * f; v1 = v1 * f;
                    } else { v0 = v0 * sc; v1 = v1 * sc; }
                    w[bj].x = cvt_pk_bf16(v0[0], v0[1]); w[bj].y = cvt_pk_bf16(v0[2], v0[3]); w[bj].z = cvt_pk_bf16(v1[0], v1[1]); w[bj].w = cvt_pk_bf16(v1[2], v1[3]);
                }
                u32x4 rcv;
#pragma unroll
                for (int j = 0; j < 4; ++j) rcv[j] = xor8(lo ? w[1][j] : w[0][j]);
                const u32x4 dA = lo ? w[0] : rcv, dB = lo ? rcv : w[1];
                bf16_t* rowA = base + (size_t)(u.pm * BM + roff + ai * HALF + m * 16 + wr * 64 + (fr & 7)) * ldc + colt + wc * 64 + 32 * (fr >> 3) + 8 * fq;
                __builtin_nontemporal_store(dA, (u32x4*)rowA);
                __builtin_nontemporal_store(dB, (u32x4*)(rowA + (size_t)8 * ldc));
            }
    }
    __device__ __forceinline__ void small(int n, int c, f32x4 v) const {
        const size_t row = (size_t)MPR + n; bf16_t* dst; float sc = 1.f; int mode = 0;
        v = v * row_rs_s(sss, n);
        if (c < 512) { dst = (bf16_t*)(ws + WS_RQ) + row * 512 + c; sc = 0.08838834764831845f; }
        else if (c < 1024) dst = (bf16_t*)(ws + WS_RK) + row * 512 + (c - 512);
        else if (c < 2048) dst = (bf16_t*)(ws + WS_RV) + row * 1024 + (c - 1024);
        else if (c < 3072) { dst = (bf16_t*)(ws + WS_RG) + row * 1024 + (c - 2048); mode = 1; }
        else if (c < 3840) { dst = (bf16_t*)(ws + WS_AQ) + row * 768 + (c - 3072); sc = 0.125f * 1.4426950408889634f; }
        else if (c < 5376) { const int kv = c >= 4608, cc = c - (kv ? 4608 : 3840), g = cc >> 8, hd = cc & 255;
            dst = (bf16_t*)(ws + (kv ? WS_AV : WS_AK)) + row * 768 + cc;
            *(f32x4*)(out + (g == 0 ? O_SKV0 : (g == 1 ? O_SKV1 : O_SKV2)) + (((size_t)layer * NS + n) * 2 + kv) * 256 + hd) = v; }
        else if (c < 6400) { dst = (bf16_t*)(ws + WS_GR) + row * 1024 + (c - 5376); mode = 2; }
        else { dst = (bf16_t*)(ws + WS_GA) + row * 1024 + (c - 6400); mode = 2; }
        if (mode == 1) {
#pragma unroll
            for (int j = 0; j < 4; ++j) v[j] = v[j] * fast_sigmoid(v[j]); }
        else if (mode == 2) {
#pragma unroll
            for (int j = 0; j < 4; ++j) v[j] = fast_sigmoid(v[j]); }
        else v = v * sc;
        u32x2 w; w.x = cvt_pk_bf16(v[0], v[1]); w.y = cvt_pk_bf16(v[2], v[3]); *(u32x2*)dst = w;
    }
    __device__ __forceinline__ void operator()(const f32x4 (&acc)[2][2][4][2], const Unit& u, int wr, int wc, int fr_, int fq_) const {
        int fr = fr_, fq = fq_; asm volatile("" : "+v"(fr), "+v"(fq));
        const int pn = u.pn;
        if (pn < 2) body<4>(acc, u, wr, wc, fr, fq, (bf16_t*)(ws + WS_RQ), 512, pn * 256, 0.08838834764831845f, 2 * pn, 0);
        else if (pn < 4) body<4>(acc, u, wr, wc, fr, fq, (bf16_t*)(ws + WS_RK), 512, (pn - 2) * 256, 1.f, 2 * (pn - 2), 1);
        else if (pn < 8) body<0>(acc, u, wr, wc, fr, fq, (bf16_t*)(ws + WS_RV), 1024, (pn - 4) * 256, 1.f, 0, 0);
        else if (pn < 12) body<1>(acc, u, wr, wc, fr, fq, (bf16_t*)(ws + WS_RG), 1024, (pn - 8) * 256, 1.f, 0, 0);
        else if (pn < 15) body<0>(acc, u, wr, wc, fr, fq, (bf16_t*)(ws + WS_AQ), 768, (pn - 12) * 256, 0.125f * 1.4426950408889634f, 0, 0);
        else if (pn < 18) body<3>(acc, u, wr, wc, fr, fq, (bf16_t*)(ws + WS_AK), 768, (pn - 15) * 256, 1.f, pn - 15, 0);
        else if (pn < 21) body<3>(acc, u, wr, wc, fr, fq, (bf16_t*)(ws + WS_AV), 768, (pn - 18) * 256, 1.f, pn - 18, 1);
        else if (pn < 25) body<2>(acc, u, wr, wc, fr, fq, (bf16_t*)(ws + WS_GR), 1024, (pn - 21) * 256, 1.f, 0, 0);
        else body<2>(acc, u, wr, wc, fr, fq, (bf16_t*)(ws + WS_GA), 1024, (pn - 25) * 256, 1.f, 0, 0);
    }
};
struct EpiAbr {
    static constexpr bool PERM = true, AFTER_DRAIN = false, ADJ = false;
    unsigned char* ws;
    __device__ __forceinline__ void small(int n, int c, f32x4 v) const { const size_t o = ((size_t)MPR + n) * DM + c; const u32x2 gw = *(const u32x2*)((const bf16_t*)(ws + WS_GA) + o);
        const f32x4 r = v * (f32x4){bf_lo(gw.x), bf_hi(gw.x), bf_lo(gw.y), bf_hi(gw.y)}; u32x2 w; w.x = cvt_pk_bf16(r[0], r[1]); w.y = cvt_pk_bf16(r[2], r[3]); *(u32x2*)((bf16_t*)(ws + WS_ABR) + o) = w; }
    __device__ __forceinline__ void operator()(const f32x4 (&acc)[2][2][4][2], const Unit& u, int wr, int wc, int fr_, int fq_) const {
        int fr = fr_, fq = fq_; asm volatile("" : "+v"(fr), "+v"(fq));
        const bf16_t* GA = (const bf16_t*)(ws + WS_GA); bf16_t* ABR = (bf16_t*)(ws + WS_ABR);
        const int row0 = u.pm * BM + wr * 64 + fr, col0 = u.pn * BM + wc * 32 + 8 * fq;
        u32x4 gq[2][2];
#pragma unroll
        for (int bj = 0; bj < 2; ++bj) gq[0][bj] = *(const u32x4*)(GA + (size_t)row0 * DM + col0 + bj * HALF);
#pragma unroll
        for (int gi = 0; gi < 8; ++gi) { const int ai = gi >> 2, m = gi & 3; const size_t off = (size_t)(row0 + ai * HALF + m * 16) * DM + col0;
            if (gi < 7) { const int ai2 = (gi + 1) >> 2, m2 = (gi + 1) & 3; const size_t off2 = (size_t)(row0 + ai2 * HALF + m2 * 16) * DM + col0;
#pragma unroll
                for (int bj = 0; bj < 2; ++bj) gq[(gi + 1) & 1][bj] = *(const u32x4*)(GA + off2 + bj * HALF); }
#pragma unroll
            for (int bj = 0; bj < 2; ++bj) { const u32x4 gw = gq[gi & 1][bj];
                const f32x4 v0 = acc[ai][bj][m][0] * (f32x4){bf_lo(gw.x), bf_hi(gw.x), bf_lo(gw.y), bf_hi(gw.y)}, v1 = acc[ai][bj][m][1] * (f32x4){bf_lo(gw.z), bf_hi(gw.z), bf_lo(gw.w), bf_hi(gw.w)};
                u32x4 w; w.x = cvt_pk_bf16(v0[0], v0[1]); w.y = cvt_pk_bf16(v0[2], v0[3]); w.z = cvt_pk_bf16(v1[0], v1[1]); w.w = cvt_pk_bf16(v1[2], v1[3]);
                *(u32x4*)(ABR + off + bj * HALF) = w; } }
    }
};
struct EpiRbr {
    static constexpr bool PERM = true, AFTER_DRAIN = false, ADJ = false;
    unsigned char* ws;
    __device__ __forceinline__ void small(int n, int c, f32x4 v) const { const size_t o = ((size_t)MPR + n) * DM + c; const u32x2 gw = *(const u32x2*)((const bf16_t*)(ws + WS_GR) + o), aw = *(const u32x2*)((const bf16_t*)(ws + WS_ABR) + o);
        const f32x4 r = v * (f32x4){bf_lo(gw.x), bf_hi(gw.x), bf_lo(gw.y), bf_hi(gw.y)} + (f32x4){bf_lo(aw.x), bf_hi(aw.x), bf_lo(aw.y), bf_hi(aw.y)};
        u32x2 w; w.x = cvt_pk_bf16(r[0], r[1]); w.y = cvt_pk_bf16(r[2], r[3]); *(u32x2*)((bf16_t*)(ws + WS_MG) + o) = w; }
    __device__ __forceinline__ void operator()(const f32x4 (&acc)[2][2][4][2], const Unit& u, int wr, int wc, int fr_, int fq_) const {
        int fr = fr_, fq = fq_; asm volatile("" : "+v"(fr), "+v"(fq));
        const bf16_t* GR = (const bf16_t*)(ws + WS_GR); const bf16_t* ABR = (const bf16_t*)(ws + WS_ABR); bf16_t* MG = (bf16_t*)(ws + WS_MG);
        const int row0 = u.pm * BM + wr * 64 + fr, col0 = u.pn * BM + wc * 32 + 8 * fq;
        u32x4 gq[2][2], aq[2][2];
#pragma unroll
        for (int bj = 0; bj < 2; ++bj) { gq[0][bj] = *(const u32x4*)(GR + (size_t)row0 * DM + col0 + bj * HALF); aq[0][bj] = *(const u32x4*)(ABR + (size_t)row0 * DM + col0 + bj * HALF); }
#pragma unroll
        for (int gi = 0; gi < 8; ++gi) { const int ai = gi >> 2, m = gi & 3; const size_t off = (size_t)(row0 + ai * HALF + m * 16) * DM + col0;
            if (gi < 7) { const int ai2 = (gi + 1) >> 2, m2 = (gi + 1) & 3; const size_t off2 = (size_t)(row0 + ai2 * HALF + m2 * 16) * DM + col0;
#pragma unroll
                for (int bj = 0; bj < 2; ++bj) { gq[(gi + 1) & 1][bj] = *(const u32x4*)(GR + off2 + bj * HALF); aq[(gi + 1) & 1][bj] = *(const u32x4*)(ABR + off2 + bj * HALF); } }
#pragma unroll
            for (int bj = 0; bj < 2; ++bj) { const u32x4 gw = gq[gi & 1][bj], aw = aq[gi & 1][bj];
                const f32x4 v0 = acc[ai][bj][m][0] * (f32x4){bf_lo(gw.x), bf_hi(gw.x), bf_lo(gw.y), bf_hi(gw.y)} + (f32x4){bf_lo(aw.x), bf_hi(aw.x), bf_lo(aw.y), bf_hi(aw.y)};
                const f32x4 v1 = acc[ai][bj][m][1] * (f32x4){bf_lo(gw.z), bf_hi(gw.z), bf_lo(gw.w), bf_hi(gw.w)} + (f32x4){bf_lo(aw.z), bf_hi(aw.z), bf_lo(aw.w), bf_hi(aw.w)};
                u32x4 w; w.x = cvt_pk_bf16(v0[0], v0[1]); w.y = cvt_pk_bf16(v0[2], v0[3]); w.z = cvt_pk_bf16(v1[0], v1[1]); w.w = cvt_pk_bf16(v1[2], v1[3]);
                *(u32x4*)(MG + off + bj * HALF) = w; } }
    }
};
struct EpiResid {
    static constexpr bool PERM = true, AFTER_DRAIN = false, ADJ = false;
    bf16_t* XB; float* ssp; float* sss;
    __device__ __forceinline__ void small(int n, int c, f32x4 v) const { const size_t o = ((size_t)MPR + n) * DM + c; const u32x2 b = *(const u32x2*)(XB + o);
        const f32x4 x = (f32x4){bf_lo(b.x), bf_hi(b.x), bf_lo(b.y), bf_hi(b.y)} + v;
        u32x2 w; w.x = cvt_pk_bf16(x[0], x[1]); w.y = cvt_pk_bf16(x[2], x[3]); *(u32x2*)(XB + o) = w;
        float s = (x[0] * x[0] + x[1] * x[1]) + (x[2] * x[2] + x[3] * x[3]); s += __shfl_xor(s, 16); s += __shfl_xor(s, 32);
        if ((lane_id() & 48) == 0) __hip_atomic_fetch_add(sss + n, s, __ATOMIC_RELAXED, __HIP_MEMORY_SCOPE_AGENT); }
    __device__ __forceinline__ void operator()(const f32x4 (&acc)[2][2][4][2], const Unit& u, int wr, int wc, int fr_, int fq_) const {
        int fr = fr_, fq = fq_; asm volatile("" : "+v"(fr), "+v"(fq));
        const int row0 = u.pm * BM + wr * 64 + fr, col0 = u.pn * BM + wc * 32 + 8 * fq;
        u32x4 bq[2][2];
#pragma unroll
        for (int bj = 0; bj < 2; ++bj) bq[0][bj] = *(const u32x4*)(XB + (size_t)row0 * DM + col0 + bj * HALF);
#pragma unroll
        for (int gi = 0; gi < 8; ++gi) { const int ai = gi >> 2, m = gi & 3, row = row0 + ai * HALF + m * 16; const size_t off = (size_t)row * DM + col0; float s = 0.f;
            if (gi < 7) { const int ai2 = (gi + 1) >> 2, m2 = (gi + 1) & 3; const size_t off2 = (size_t)(row0 + ai2 * HALF + m2 * 16) * DM + col0;
#pragma unroll
                for (int bj = 0; bj < 2; ++bj) bq[(gi + 1) & 1][bj] = *(const u32x4*)(XB + off2 + bj * HALF); }
#pragma unroll
            for (int bj = 0; bj < 2; ++bj) { const u32x4 b = bq[gi & 1][bj];
                const f32x4 x0 = (f32x4){bf_lo(b.x), bf_hi(b.x), bf_lo(b.y), bf_hi(b.y)} + acc[ai][bj][m][0], x1 = (f32x4){bf_lo(b.z), bf_hi(b.z), bf_lo(b.w), bf_hi(b.w)} + acc[ai][bj][m][1];
                u32x4 w; w.x = cvt_pk_bf16(x0[0], x0[1]); w.y = cvt_pk_bf16(x0[2], x0[3]); w.z = cvt_pk_bf16(x1[0], x1[1]); w.w = cvt_pk_bf16(x1[2], x1[3]);
                *(u32x4*)(XB + off + bj * HALF) = w;
                s += ((x0[0] * x0[0] + x0[1] * x0[1]) + (x0[2] * x0[2] + x0[3] * x0[3])) + ((x1[0] * x1[0] + x1[1] * x1[1]) + (x1[2] * x1[2] + x1[3] * x1[3])); }
            s += __shfl_xor(s, 16); s += __shfl_xor(s, 32);
            if (fq == 0) __hip_atomic_fetch_add(ssp + row, s, __ATOMIC_RELAXED, __HIP_MEMORY_SCOPE_AGENT);
        }
    }
};
struct EpiSwiglu {
    static constexpr bool PERM = true, AFTER_DRAIN = false, ADJ = false;
    bf16_t* H; const float* ssp; const float* sss; int rs_row0;
    __device__ __forceinline__ void small2(int n, int j, f32x4 g, f32x4 up) const { f32x4 r; const float rs = row_rs_s(sss, n); g = g * rs; up = up * rs;
#pragma unroll
        for (int i = 0; i < 4; ++i) r[i] = g[i] * fast_sigmoid(g[i]) * up[i];
        u32x2 w; w.x = cvt_pk_bf16(r[0], r[1]); w.y = cvt_pk_bf16(r[2], r[3]); *(u32x2*)(H + ((size_t)MPR + n) * DFF + j) = w; }
    __device__ __forceinline__ void operator()(const f32x4 (&acc)[2][2][4][2], const Unit& u, int wr, int wc, int fr_, int fq_) const {
        int fr = fr_, fq = fq_; asm volatile("" : "+v"(fr), "+v"(fq));
        const int nai = u.half < 0 ? 2 : 1;
        const int row0 = u.pm * BM + (u.half > 0 ? HALF : 0) + wr * 64 + fr, col0 = u.pn * HALF + wc * 32 + 8 * fq;
        const int tb = ((unsigned)(u.pm * BM - rs_row0) < (unsigned)RS_LDS_ROWS) ? u.pm * BM - rs_row0 : RS_LDS_ROWS;
        float rsv[2][4];
#pragma unroll
        for (int ai = 0; ai < 2; ++ai)
#pragma unroll
            for (int m = 0; m < 4; ++m) { const int row = row0 + ai * HALF + m * 16; rsv[ai][m] = (ai < nai) ? (rs_row0 >= 0 ? rs_tab(row - u.pm * BM + tb) : row_rs(ssp, row)) : 0.f; }
#pragma unroll
        for (int ai = 0; ai < 2; ++ai) if (ai < nai)
#pragma unroll
            for (int m = 0; m < 4; ++m) { f32x4 v0, v1; const float rs = rsv[ai][m];
#pragma unroll
                for (int j = 0; j < 4; ++j) { const float g0 = acc[ai][0][m][0][j] * rs, g1 = acc[ai][0][m][1][j] * rs; v0[j] = g0 * fast_sigmoid(g0) * (acc[ai][1][m][0][j] * rs); v1[j] = g1 * fast_sigmoid(g1) * (acc[ai][1][m][1][j] * rs); }
                u32x4 w; w.x = cvt_pk_bf16(v0[0], v0[1]); w.y = cvt_pk_bf16(v0[2], v0[3]); w.z = cvt_pk_bf16(v1[0], v1[1]); w.w = cvt_pk_bf16(v1[2], v1[3]);
                *(u32x4*)(H + (size_t)(row0 + ai * HALF + m * 16) * DFF + col0) = w; }
    }
};
template <class Epi, class Sched, bool ALIGN_EPI = false, bool SP2 = false>
__device__ __forceinline__ void gemm_phase(PG8_LAS unsigned char* lds, const Gemm g, const Sched& S, const Epi& E, const int wave0) {
    int tid_ = wave0 * 64 + lane_id(); asm volatile("" : "+v"(tid_));
    const int tid = tid_, wid = __builtin_amdgcn_readfirstlane(tid >> 6), lane = tid & 63, wr = wid >> 2, wc = wid & 3, fr = lane & 15, fq = lane >> 4;
    const int K = g.K, nt = K / BK;
    unsigned voffA[2], voffB[2];
#pragma unroll
    for (int i = 0; i < 2; ++i) { int R, C; stage_rc(tid * 16 + i * 8192, R, C); const int Rb = Epi::ADJ ? (2 * (R & ~31) + perm32(R & 31)) : (Epi::PERM ? ((R & ~31) + perm32(R & 31)) : R);
        voffA[i] = (unsigned)(R * K + C) * 2u; voffB[i] = (unsigned)(Rb * K + C) * 2u; }
    const size_t kstep = (size_t)(BK * 2);
    const size_t hstep = (size_t)HALF * K * 2;
    const size_t hstepB = Epi::ADJ ? (size_t)32 * K * 2 : hstep;
    const size_t tstep = 2 * hstep;
    const unsigned ldsw = (unsigned)wid * 1024u;
    const int aoff = lds_byte(wr * 64 + fr, fq * 8), boff = lds_byte(wc * 32 + fr, fq * 8);
#define PG8_SA(b, h) (((b) * 2 + (h)) * HTB)
#define PG8_SB(b, h) ((4 + (b) * 2 + (h)) * HTB)
#define PG8_STAGE(bufoff, gbase, voff) do { _Pragma("unroll") for (int _i = 0; _i < 2; ++_i) \
        __builtin_amdgcn_global_load_lds((const unsigned*)((const char*)(gbase) + (voff)[_i]), (PG8_LAS unsigned*)(lds + (bufoff) + ldsw + _i * 8192), 16, 0, 0); } while (0)
#define PG8_LDA(dst, b, h) do { _Pragma("unroll") for (int m = 0; m < 4; ++m) _Pragma("unroll") for (int k = 0; k < 2; ++k) dst[m][k] = *(const PG8_LAS bf16x8*)(lds + PG8_SA(b, h) + aoff + m * 2048 + k * 1024); } while (0)
#define PG8_LDB(dst, b, h) do { _Pragma("unroll") for (int n = 0; n < 2; ++n) _Pragma("unroll") for (int k = 0; k < 2; ++k) dst[n][k] = *(const PG8_LAS bf16x8*)(lds + PG8_SB(b, h) + boff + n * 2048 + k * 1024); } while (0)
#define PG8_MMA(ai, bj, At, Bt) do { __builtin_amdgcn_s_setprio(1); _Pragma("unroll") for (int m = 0; m < 4; ++m) _Pragma("unroll") for (int n = 0; n < 2; ++n) _Pragma("unroll") for (int k = 0; k < 2; ++k) \
        acc[ai][bj][m][n] = __builtin_amdgcn_mfma_f32_16x16x32_bf16(Bt[n][k], At[m][k], acc[ai][bj][m][n], 0, 0, 0); __builtin_amdgcn_s_setprio(0); } while (0)
#define PG8_WAIT_V(n) asm volatile("s_waitcnt vmcnt(" #n ")" ::: "memory")
#define PG8_WAIT_L(n) asm volatile("s_waitcnt lgkmcnt(" #n ")" ::: "memory")
#define PG8_BAR __builtin_amdgcn_s_barrier()
#define PG8_SCHED __builtin_amdgcn_sched_barrier(0)
    Unit cur, nxt; int ui = 0;
    if (!S.next(0, cur)) return;
    f32x4 acc[2][2][4][2];
#pragma unroll
    for (int a = 0; a < 2; ++a)
#pragma unroll
        for (int b = 0; b < 2; ++b)
#pragma unroll
            for (int m = 0; m < 4; ++m)
#pragma unroll
                for (int n = 0; n < 2; ++n) acc[a][b][m][n] = (f32x4){0.f, 0.f, 0.f, 0.f};
    bf16x8 At[4][2], B0[2][2], B1[2][2];
    const char* cA = (const char*)g.A + (size_t)cur.pm * tstep + (cur.half > 0 ? hstep : (size_t)0); const char* cB = (const char*)g.Bt + (size_t)cur.pn * tstep;
    S.a_ready(cur);
    if constexpr (SP2) {
        PG8_STAGE(PG8_SB(0, 0), cB, voffB); PG8_STAGE(PG8_SB(0, 1), cB + hstepB, voffB); PG8_STAGE(PG8_SA(0, 0), cA, voffA); PG8_STAGE(PG8_SA(0, 1), cA + hstep, voffA);
        if (wr == 1) PG8_BAR;
        PG8_WAIT_V(2); PG8_BAR;
        PG8_STAGE(PG8_SB(1, 0), cB + kstep, voffB); PG8_STAGE(PG8_SA(1, 0), cA + kstep, voffA); PG8_STAGE(PG8_SB(1, 1), cB + hstepB + kstep, voffB);
        PG8_WAIT_V(6); PG8_BAR;
    } else {
        PG8_STAGE(PG8_SB(0, 0), cB, voffB); PG8_STAGE(PG8_SA(0, 0), cA, voffA); PG8_STAGE(PG8_SB(0, 1), cB + hstepB, voffB); PG8_STAGE(PG8_SA(0, 1), cA + hstep, voffA);
        if (wr == 1) PG8_BAR;
        PG8_WAIT_V(4); PG8_BAR;
        PG8_STAGE(PG8_SB(1, 0), cB + kstep, voffB); PG8_STAGE(PG8_SA(1, 0), cA + kstep, voffA); PG8_STAGE(PG8_SB(1, 1), cB + hstepB + kstep, voffB);
        PG8_WAIT_V(6); PG8_BAR;
    }
    for (;;) {
        const bool has_next = S.next(ui + 1, nxt);
        const char* nA = has_next ? (const char*)g.A + (size_t)nxt.pm * tstep + (nxt.half > 0 ? hstep : (size_t)0) : cA; const char* nB = has_next ? (const char*)g.Bt + (size_t)nxt.pn * tstep : cB;
        const bool full = cur.half < 0;
#pragma unroll 1
        for (int t = 0; t < nt; t += 2) {
            const bool last = (t == nt - 2);
            const char* a1 = cA + (size_t)(t + 1) * kstep;
            const char* a2 = last ? nA : cA + (size_t)(t + 2) * kstep; const char* b2 = last ? nB : cB + (size_t)(t + 2) * kstep;
            const char* a3 = a2 + kstep; const char* b3 = b2 + kstep;
            if (last && has_next) S.a_ready(nxt);
            if constexpr (SP2) {
            PG8_LDB(B0, 0, 0); PG8_LDB(B1, 0, 1); PG8_SCHED; PG8_LDA(At, 0, 0); PG8_STAGE(PG8_SA(1, 1), a1 + hstep, voffA);
            PG8_WAIT_V(8); PG8_WAIT_L(0); PG8_BAR; PG8_MMA(0, 0, At, B0); PG8_MMA(0, 1, At, B1); PG8_BAR; PG8_SCHED;
            PG8_LDA(At, 0, 1); PG8_STAGE(PG8_SB(0, 0), b2, voffB); PG8_STAGE(PG8_SB(0, 1), b2 + hstepB, voffB); PG8_STAGE(PG8_SA(0, 0), a2, voffA);
            PG8_WAIT_V(8); PG8_WAIT_L(0); PG8_BAR; if (full) { PG8_MMA(1, 0, At, B0); PG8_MMA(1, 1, At, B1); } PG8_BAR; PG8_SCHED;
            PG8_LDB(B0, 1, 0); PG8_LDB(B1, 1, 1); PG8_SCHED; PG8_LDA(At, 1, 0); PG8_STAGE(PG8_SA(0, 1), a2 + hstep, voffA);
            PG8_WAIT_V(8); PG8_WAIT_L(0); PG8_BAR; PG8_MMA(0, 0, At, B0); PG8_MMA(0, 1, At, B1); PG8_BAR; PG8_SCHED;
            PG8_LDA(At, 1, 1); PG8_STAGE(PG8_SB(1, 0), b3, voffB); PG8_STAGE(PG8_SB(1, 1), b3 + hstepB, voffB); PG8_STAGE(PG8_SA(1, 0), a3, voffA);
            PG8_WAIT_V(8); PG8_WAIT_L(0); PG8_BAR; if (full) { PG8_MMA(1, 0, At, B0); PG8_MMA(1, 1, At, B1); } PG8_BAR; PG8_SCHED;
            } else {
            PG8_LDB(B0, 0, 0); PG8_SCHED; PG8_LDA(At, 0, 0); PG8_STAGE(PG8_SA(1, 1), a1 + hstep, voffA);
            PG8_WAIT_L(8); PG8_BAR; PG8_WAIT_L(0); PG8_MMA(0, 0, At, B0); PG8_BAR; PG8_SCHED;
            PG8_LDB(B1, 0, 1); PG8_STAGE(PG8_SB(0, 0), b2, voffB);
            PG8_BAR; PG8_WAIT_L(0); PG8_MMA(0, 1, At, B1); PG8_BAR;
            PG8_LDA(At, 0, 1); PG8_STAGE(PG8_SA(0, 0), a2, voffA);
            PG8_BAR; PG8_WAIT_L(0); PG8_MMA(1, 0, At, B0); PG8_BAR; PG8_SCHED;
            PG8_STAGE(PG8_SB(0, 1), b2 + hstepB, voffB);
            PG8_WAIT_V(6); PG8_BAR; PG8_MMA(1, 1, At, B1); PG8_BAR;
            PG8_LDB(B0, 1, 0); PG8_SCHED; PG8_LDA(At, 1, 0); PG8_STAGE(PG8_SA(0, 1), a2 + hstep, voffA);
            PG8_WAIT_L(8); PG8_BAR; PG8_WAIT_L(0); PG8_MMA(0, 0, At, B0); PG8_BAR; PG8_SCHED;
            PG8_LDB(B1, 1, 1); PG8_STAGE(PG8_SB(1, 0), b3, voffB);
            PG8_BAR; PG8_WAIT_L(0); PG8_MMA(0, 1, At, B1); PG8_BAR;
            PG8_LDA(At, 1, 1); PG8_STAGE(PG8_SA(1, 0), a3, voffA);
            PG8_BAR; PG8_WAIT_L(0); PG8_MMA(1, 0, At, B0); PG8_BAR; PG8_SCHED;
            PG8_STAGE(PG8_SB(1, 1), b3 + hstepB, voffB);
            PG8_WAIT_V(6); PG8_BAR; PG8_MMA(1, 1, At, B1); PG8_BAR;
            }
        }
        if constexpr (ALIGN_EPI) { if (wr == 0) PG8_BAR; }
        if constexpr (!Epi::AFTER_DRAIN) { E(acc, cur, wr, wc, fr, fq); S.done(cur); }
        if (!has_next) break;
#pragma unroll
        for (int a = 0; a < 2; ++a)
#pragma unroll
            for (int b = 0; b < 2; ++b)
#pragma unroll
                for (int m = 0; m < 4; ++m)
#pragma unroll
                    for (int n = 0; n < 2; ++n) acc[a][b][m][n] = (f32x4){0.f, 0.f, 0.f, 0.f};
        cur = nxt; cA = nA; cB = nB; ++ui;
        if constexpr (ALIGN_EPI) { if (wr == 1) PG8_BAR; }
    }
    PG8_WAIT_V(0);
    if constexpr (!ALIGN_EPI) { if (wr == 0) PG8_BAR; }
    PG8_BAR;
    if constexpr (Epi::AFTER_DRAIN) { E.fused(acc, cur, wr, wc, fr, fq, lds, wid, lane); S.done(cur); }
#undef PG8_SA
#undef PG8_SB
#undef PG8_STAGE
#undef PG8_LDA
#undef PG8_LDB
#undef PG8_MMA
#undef PG8_WAIT_V
#undef PG8_WAIT_L
#undef PG8_BAR
#undef PG8_SCHED
}
}
#define GAS __attribute__((address_space(1)))
#define LAS __attribute__((address_space(3)))
typedef unsigned short bf16;
typedef unsigned v4u __attribute__((ext_vector_type(4)));
typedef float f32x4 __attribute__((ext_vector_type(4)));
typedef short bf16x8 __attribute__((ext_vector_type(8)));
typedef GAS unsigned gu32;
typedef GAS unsigned long long gu64;
#define RLX_AGENT __ATOMIC_RELAXED, __HIP_MEMORY_SCOPE_AGENT
#define LDS_WAIT() asm volatile("s_waitcnt lgkmcnt(0)" ::: "memory")
#define VM_WAIT() asm volatile("s_waitcnt vmcnt(0)" ::: "memory")
__device__ __forceinline__ unsigned long long rt() { return __builtin_amdgcn_s_memrealtime(); }
__device__ __forceinline__ unsigned f2bf(float f) { unsigned u = __builtin_bit_cast(unsigned, f); return (u + 0x7fffu + ((u >> 16) & 1u)) >> 16; }
__device__ __forceinline__ unsigned pk2(float lo, float hi) { return f2bf(lo) | (f2bf(hi) << 16); }

#define XB_TMO      128
#define XB_XCNT(j)  (256  + 64 * (j))
#define XB_XSUB(j)  (1280 + 64 * (j))
#define XB_XGEN(j)  (2304 + 64 * (j))
#define XB_TOP      3328
#define XB_TOPGEN   3392
#define XCD_BAR_WORDS 3456
#define XB_SPIN_CAP (1u << 18)

__device__ __forceinline__ unsigned xb_ld(unsigned* p)              { return __hip_atomic_load(p, __ATOMIC_RELAXED, __HIP_MEMORY_SCOPE_AGENT); }
__device__ __forceinline__ unsigned xb_add(unsigned* p, unsigned v) { return __hip_atomic_fetch_add(p, v, __ATOMIC_RELAXED, __HIP_MEMORY_SCOPE_AGENT); }
__device__ __forceinline__ unsigned xb_xcc_id() { return (unsigned)__builtin_amdgcn_s_getreg((3 << 11) | 20) & 0xFu; }
#define XB_SPIN(cond, bar) do { unsigned _sp = 0; while (cond) { __builtin_amdgcn_s_sleep(1); \
    if ((++_sp & 255u) == 0u) { if (xb_ld(&(bar)[XB_TMO])) break; if (_sp > XB_SPIN_CAP) { atomicAdd(&(bar)[XB_TMO], 1u); break; } } } } while (0)

struct XcdBarrier {
    unsigned* bar; unsigned x; unsigned w0;
    volatile LAS unsigned* st;
};

__device__ __forceinline__ XcdBarrier xcd_barrier_post(unsigned* bar, volatile LAS unsigned* st) {
    XcdBarrier b; b.bar = bar; b.x = xb_xcc_id(); b.st = st; b.w0 = (unsigned)__builtin_amdgcn_readfirstlane((int)(threadIdx.x >> 6));
    if (threadIdx.x == 0) (void)xb_add(&bar[XB_XCNT(b.x)], 1u);
    return b;
}
__device__ __forceinline__ void xcd_barrier_complete(unsigned* bar, unsigned x, unsigned& nloc, unsigned& nx) {
    const unsigned G = gridDim.x * gridDim.y * gridDim.z;
    unsigned sum, cnt, mine, sp = 0u;
    for (;;) {
        sum = 0u; cnt = 0u; mine = 0u;
#pragma unroll
        for (unsigned j = 0; j < 16; ++j) { const unsigned c = xb_ld(&bar[XB_XCNT(j)]); sum += c; cnt += (c > 0u) ? 1u : 0u; mine = (j == x) ? c : mine; }
        if (sum == G) break;
        __builtin_amdgcn_s_sleep(1);
        if ((++sp & 255u) == 0u) { if (xb_ld(&bar[XB_TMO])) break; if (sp > XB_SPIN_CAP) { atomicAdd(&bar[XB_TMO], 1u); break; } }
    }
    nloc = mine > 0u ? mine : 1u; nx = cnt > 0u ? cnt : 1u;
}

__device__ __forceinline__ void xcd_barrier(const XcdBarrier& b) {
    asm volatile("s_waitcnt vmcnt(0)" ::: "memory");
    __syncthreads();
    if (b.w0 == 0u && lane_id() == 0) {
        unsigned* bar = b.bar;
        __builtin_amdgcn_s_waitcnt(0);
        unsigned nloc = b.st[0], nx = b.st[1];
        if (nloc == 0u) { xcd_barrier_complete(bar, b.x, nloc, nx); b.st[0] = nloc; b.st[1] = nx; }
        const unsigned old = xb_add(&bar[XB_XSUB(b.x)], 1u);
        const unsigned gen = old / nloc;
        if (old + 1u == (gen + 1u) * nloc) {
            __builtin_amdgcn_fence(__ATOMIC_RELEASE, "agent");
            asm volatile("s_waitcnt vmcnt(0)" ::: "memory");
            __builtin_amdgcn_fence(__ATOMIC_ACQUIRE, "agent");
            const unsigned og = xb_add(&bar[XB_TOP], 1u);
            const unsigned tg = og / nx;
            if (og + 1u == (tg + 1u) * nx) xb_add(&bar[XB_TOPGEN], 1u);
            else XB_SPIN(xb_ld(&bar[XB_TOPGEN]) == tg, bar);
            asm volatile("s_waitcnt vmcnt(0)" ::: "memory");
        } else {
            __builtin_amdgcn_fence(__ATOMIC_ACQUIRE, "agent");
            XB_SPIN(xb_ld(&bar[XB_TOPGEN]) <= gen, bar);
            asm volatile("s_waitcnt vmcnt(0)" ::: "memory");
        }
    }
    __syncthreads();
}
__device__ __forceinline__ float wave_sum(float v) {
#pragma unroll
    for (int o = 1; o < 64; o <<= 1) v += __shfl_xor(v, o);
    return v;
}
__device__ __forceinline__ void p0_transpose_item(const float* W, int K, int N, bf16* WT, int row_off, LAS float* scr, int item, int lane) {
    const int nblk = N / 32, kb = item / nblk, nb = item % nblk, k0 = 64 * kb, n0 = 32 * nb;
#pragma unroll 8
    for (int i = 0; i < 32; ++i) { const int kk = 2 * i + (lane >> 5); scr[kk * 33 + (lane & 31)] = W[(size_t)(k0 + kk) * N + n0 + (lane & 31)]; }
    LDS_WAIT(); asm volatile("" ::: "memory");
    const int c = lane & 7;
#pragma unroll
    for (int j = 0; j < 4; ++j) { const int n = (lane >> 3) + 8 * j; const LAS float* s = scr + (8 * c) * 33 + n;
        v4u o; o.x = pk2(s[0 * 33], s[1 * 33]); o.y = pk2(s[2 * 33], s[3 * 33]); o.z = pk2(s[4 * 33], s[5 * 33]); o.w = pk2(s[6 * 33], s[7 * 33]);
        *(GAS v4u*)(WT + (size_t)(row_off + n0 + n) * K + k0 + 8 * c) = o; }
    LDS_WAIT(); asm volatile("" ::: "memory");
}
struct Args { const float* in[15]; float* out; unsigned char* ws; int ph_lo, ph_hi; };
struct Ctx { LAS unsigned char* lds; int tid, lane, wave, vcu, G; };
__device__ __forceinline__ Ctx make_ctx(LAS unsigned char* lds, int wave0) { Ctx F; F.lds = lds; int t = wave0 * 64 + lane_id(); asm volatile("" : "+v"(t)); F.tid = t; F.lane = t & 63; F.wave = wave0;
    F.G = gridDim.x; { const int bx = blockIdx.x; F.vcu = (F.G % 8 == 0) ? (bx % 8) * (F.G / 8) + bx / 8 : bx; } return F; }
struct Ptrs {
    const float *xp, *xs, *state, *c0, *c1, *c2, *norm_mix, *w_in, *w_ret, *w_att, *w_out, *norm_ffn, *w_gu, *w_dn, *norm_final;
    float* out; unsigned char* ws;
    float *XF, *KVC, *SC, *ABR; bf16 *HN, *RQ, *RK, *RV, *RG, *AQ, *AK, *AV, *GR, *GA, *RO, *AO, *MG, *H;
};
typedef const __attribute__((address_space(4))) Args* KArgs;
__device__ __forceinline__ Ptrs late_ptrs() {
    KArgs a = (KArgs)__builtin_amdgcn_kernarg_segment_ptr();
    asm volatile("" : "+s"(a));
    Ptrs P; unsigned char* ws = a->ws; P.ws = ws; P.out = a->out;
    P.xp = a->in[0]; P.xs = a->in[1]; P.state = a->in[2]; P.c0 = a->in[3]; P.c1 = a->in[4]; P.c2 = a->in[5]; P.norm_mix = a->in[6]; P.w_in = a->in[7];
    P.w_ret = a->in[8]; P.w_att = a->in[9]; P.w_out = a->in[10]; P.norm_ffn = a->in[11]; P.w_gu = a->in[12]; P.w_dn = a->in[13]; P.norm_final = a->in[14];
    P.XF = (float*)(ws + WS_XF); P.HN = (bf16*)(ws + WS_HN); P.RQ = (bf16*)(ws + WS_RQ); P.RK = (bf16*)(ws + WS_RK); P.RV = (bf16*)(ws + WS_RV); P.RG = (bf16*)(ws + WS_RG);
    P.AQ = (bf16*)(ws + WS_AQ); P.AK = (bf16*)(ws + WS_AK); P.AV = (bf16*)(ws + WS_AV); P.GR = (bf16*)(ws + WS_GR); P.GA = (bf16*)(ws + WS_GA);
    P.KVC = (float*)(ws + WS_KVC); P.SC = (float*)(ws + WS_SC); P.RO = (bf16*)(ws + WS_RO); P.AO = (bf16*)(ws + WS_AO); P.ABR = (float*)(ws + WS_ABR); P.MG = (bf16*)(ws + WS_MG); P.H = (bf16*)(ws + WS_H);
    return P;
}
__device__ __forceinline__ float bf2f(bf16 b) { return __builtin_bit_cast(float, ((unsigned)b) << 16); }
__device__ __forceinline__ float log_gamma_h(int h) { return log1pf(-exp2f(-5.0f - (float)h)); }

__device__ __forceinline__ void p0_item(const float* W, int K, int N, bf16* WT, LAS float* scr, int kb, int nb, int drow0, int lane, const float* gain = nullptr) {
    const int k0 = 64 * kb, n0 = 32 * nb;
    float wv[32];
#pragma unroll
    for (int i = 0; i < 32; ++i) { const int kk = 2 * i + (lane >> 5); wv[i] = W[(size_t)(k0 + kk) * N + n0 + (lane & 31)]; }
    const float g0 = gain ? gain[k0 + (lane >> 5) + 2 * (lane & 31)] : 1.f;
#pragma unroll
    for (int i = 0; i < 32; ++i) { const int kk = 2 * i + (lane >> 5); scr[kk * 33 + (lane & 31)] = wv[i] * __shfl(g0, i + (lane & 32)); }
    LDS_WAIT(); asm volatile("" ::: "memory");
    const int c = lane & 7;
#pragma unroll
    for (int j = 0; j < 4; ++j) { const int n = (lane >> 3) + 8 * j; const LAS float* s = scr + (8 * c) * 33 + n;
        v4u o; o.x = pk2(s[0 * 33], s[1 * 33]); o.y = pk2(s[2 * 33], s[3 * 33]); o.z = pk2(s[4 * 33], s[5 * 33]); o.w = pk2(s[6 * 33], s[7 * 33]);
        *(GAS v4u*)(WT + (size_t)(drow0 + n) * K + k0 + 8 * c) = o; }
    LDS_WAIT(); asm volatile("" ::: "memory");
}
__device__ __forceinline__ void norm_row(const float* src, const float* g, bf16* orow, float* copy, int lane) {
    f32x4 v[4]; float s = 0.f;
#pragma unroll
    for (int j = 0; j < 4; ++j) { v[j] = src ? ((const GAS f32x4*)src)[lane + 64 * j] : (f32x4){0.f, 0.f, 0.f, 0.f}; s += (v[j].x * v[j].x + v[j].y * v[j].y) + (v[j].z * v[j].z + v[j].w * v[j].w); }
    const float rs = 1.f / sqrtf(wave_sum(s) * (1.f / DM) + RMS_EPS);
    GAS unsigned long long* o8 = (GAS unsigned long long*)orow + lane;
#pragma unroll
    for (int j = 0; j < 4; ++j) { const f32x4 gg = ((const GAS f32x4*)g)[lane + 64 * j];
        if (copy) ((GAS f32x4*)copy)[lane + 64 * j] = v[j];
        o8[64 * j] = (unsigned long long)pk2(v[j].x * rs * gg.x, v[j].y * rs * gg.y) | ((unsigned long long)pk2(v[j].z * rs * gg.z, v[j].w * rs * gg.w) << 32); }
}
constexpr int I_IN = 16 * (DIN / 32), I_RET = 16 * 32, I_ATT = 4 * 32, I_OUT = 16 * 32, I_GU = 16 * (2 * DFF / 32), I_DN = (DFF / 64) * 32, I_LAYER = I_IN + I_RET + I_ATT + I_OUT + I_GU + I_DN;
__device__ __forceinline__ void convert_weights(const Ctx& F, const Ptrs& P, int it_lo, int it_hi, int gw, int NGW) {
    LAS float* scr = (LAS float*)(F.lds + F.wave * 16384);
    for (int it = it_lo + gw; it < it_hi; it += NGW) {
        const int l = it / I_LAYER; int r = it % I_LAYER; unsigned char* wl = P.ws + WS_W + (size_t)l * W_LAYER;
        if (r < I_IN) { const int nblk = DIN / 32; p0_item(P.w_in + (size_t)l * DM * DIN, DM, DIN, (bf16*)(wl + W_IN), scr, r / nblk, r % nblk, 32 * (r % nblk), F.lane, P.norm_mix + (size_t)l * DM); continue; } r -= I_IN;
        if (r < I_RET) { p0_item(P.w_ret + (size_t)l * DM * DM, DM, DM, (bf16*)(wl + W_RET), scr, r / 32, r % 32, 32 * (r % 32), F.lane); continue; } r -= I_RET;
        if (r < I_ATT) { p0_item(P.w_att + (size_t)l * 256 * DM, 256, DM, (bf16*)(wl + W_ATT), scr, r / 32, r % 32, 32 * (r % 32), F.lane); continue; } r -= I_ATT;
        if (r < I_OUT) { p0_item(P.w_out + (size_t)l * DM * DM, DM, DM, (bf16*)(wl + W_OUT), scr, r / 32, r % 32, 32 * (r % 32), F.lane); continue; } r -= I_OUT;
        if (r < I_GU) { const int nblk = 2 * DFF / 32, nb = r % nblk, n0 = 32 * nb; const int isup = n0 >= DFF, nn = isup ? n0 - DFF : n0, drow = 256 * (nn / 128) + 128 * isup + (nn % 128);
            p0_item(P.w_gu + (size_t)l * DM * 2 * DFF, DM, 2 * DFF, (bf16*)(wl + W_GU), scr, r / nblk, nb, drow, F.lane, P.norm_ffn + (size_t)l * DM); continue; } r -= I_GU;
        p0_item(P.w_dn + (size_t)l * DFF * DM, DFF, DM, (bf16*)(wl + W_DN), scr, r / 32, r % 32, 32 * (r % 32), F.lane);
    }
}
__device__ __forceinline__ void ph_prologue(const Ctx& F, const Ptrs& P) {
    const int gw = F.vcu * NWAVES + F.wave, NGW = F.G * NWAVES;
    convert_weights(F, P, 0, I_IN, gw, NGW);
    bf16* XB = (bf16*)(P.ws + WS_XB); float* SSP = (float*)(P.ws + WS_SSP); float* SSS = (float*)(P.ws + WS_SSS);
    for (int m0 = gw; m0 < MR; m0 += 2 * NGW) {
        f32x4 v[2][4];
#pragma unroll
        for (int q = 0; q < 2; ++q) { const int m = m0 + q * NGW; if (m < MR) { const float* src = (m < MPR) ? P.xp + (size_t)m * DM : P.xs + (size_t)(m - MPR) * DM;
#pragma unroll
            for (int j = 0; j < 4; ++j) v[q][j] = ((const GAS f32x4*)src)[F.lane + 64 * j]; } }
#pragma unroll
        for (int q = 0; q < 2; ++q) { const int m = m0 + q * NGW; if (m < MR) { float ss = 0.f;
#pragma unroll
            for (int j = 0; j < 4; ++j) ss += (v[q][j].x * v[q][j].x + v[q][j].y * v[q][j].y) + (v[q][j].z * v[q][j].z + v[q][j].w * v[q][j].w);
            ss = wave_sum(ss);
            GAS unsigned long long* o8 = (GAS unsigned long long*)(XB + (size_t)m * DM) + F.lane;
#pragma unroll
            for (int j = 0; j < 4; ++j) o8[64 * j] = (unsigned long long)pk2(v[q][j].x, v[q][j].y) | ((unsigned long long)pk2(v[q][j].z, v[q][j].w) << 32);
            if (F.lane == 0) { if (m < MPR) SSP[m] = ss; else SSS[m - MPR] = ss; } } } }
    for (int i = F.vcu * NTHR + F.tid; i < 4 * NS; i += F.G * NTHR) SSS[NS + i] = 0.f;
    for (int i = F.vcu * NTHR + F.tid; i < 4 * MPR; i += F.G * NTHR) SSP[MPR + i] = 0.f;
}
__device__ __forceinline__ void ph_rmsnorm(const Ctx& F, const Ptrs& P, const float* g) {
    const int gw = F.vcu * NWAVES + F.wave, NGW = F.G * NWAVES;
    for (int m = gw; m < MP; m += NGW) norm_row(P.XF + (size_t)m * DM, g, P.HN + (size_t)m * DM, nullptr, F.lane);
}
__device__ __forceinline__ void ph_final_norm(const Ctx& F, const Ptrs& P) {
    const int gw = F.vcu * NWAVES + F.wave, NGW = F.G * NWAVES, lane = F.lane;
    const float* SSP = (const float*)(P.ws + WS_SSP) + (size_t)4 * MPR; const float* SSS = (const float*)(P.ws + WS_SSS) + 4 * NS;
    f32x4 gg[4];
#pragma unroll
    for (int j = 0; j < 4; ++j) gg[j] = ((const GAS f32x4*)P.norm_final)[lane + 64 * j];
    const bf16* XB = (const bf16*)(P.ws + WS_XB);
    for (int m0 = gw; m0 < MR; m0 += 2 * NGW) {
        unsigned long long v[2][4]; float ssq[2] = {1.f, 1.f};
#pragma unroll
        for (int q = 0; q < 2; ++q) { const int m = m0 + q * NGW; if (m < MR) { const GAS unsigned long long* xr = (const GAS unsigned long long*)(XB + (size_t)m * DM) + lane;
#pragma unroll
            for (int j = 0; j < 4; ++j) v[q][j] = xr[64 * j];
            ssq[q] = (m < MPR) ? SSP[m] : SSS[m - MPR]; } }
#pragma unroll
        for (int q = 0; q < 2; ++q) { const int m = m0 + q * NGW; if (m < MR) { const float rs = 1.f / sqrtf(ssq[q] * (1.f / DM) + RMS_EPS);
            float* orow = (m < MPR) ? P.out + O_YP + (size_t)m * DM : P.out + O_YS + (size_t)(m - MPR) * DM;
#pragma unroll
            for (int j = 0; j < 4; ++j) { const unsigned lo = (unsigned)v[q][j], hi = (unsigned)(v[q][j] >> 32);
                const f32x4 x = (f32x4){bf2f((bf16)(lo & 0xffff)), bf2f((bf16)(lo >> 16)), bf2f((bf16)(hi & 0xffff)), bf2f((bf16)(hi >> 16))};
                ((GAS f32x4*)orow)[lane + 64 * j] = x * rs * gg[j]; } } }
    }
}
typedef short s16x4 __attribute__((ext_vector_type(4)));
typedef short v4i16_t __attribute__((ext_vector_type(4)));
typedef unsigned u32x2v __attribute__((ext_vector_type(2)));
typedef float f32x2s __attribute__((ext_vector_type(2)));
__device__ __forceinline__ f32x4 mfma16(bf16x8 x, bf16x8 y, f32x4 c) { return __builtin_amdgcn_mfma_f32_16x16x32_bf16(x, y, c, 0, 0, 0); }
__device__ __forceinline__ s16x4 tr4(LAS unsigned char* p) { return __builtin_bit_cast(s16x4, __builtin_amdgcn_ds_read_tr16_b64_v4i16((LAS v4i16_t*)p)); }
__device__ __forceinline__ bf16x8 tr_frag(LAS unsigned char* img, int rs, int ra, int rb, int n0, int lane) {
    const int fq = lane >> 4, q = (lane & 15) >> 2, p = lane & 3;
    const s16x4 a = tr4(img + (ra + 4 * fq + q) * rs + (n0 + 4 * p) * 2), b = tr4(img + (rb + 4 * fq + q) * rs + (n0 + 4 * p) * 2);
    return (bf16x8){a[0], a[1], a[2], a[3], b[0], b[1], b[2], b[3]};
}
constexpr int KS_ = 288, VS_ = 544, KIMG = 0, VIMG = 128 * KS_;
static_assert(VIMG + 128 * VS_ <= RING_BYTES, "retention LDS images");
__device__ __forceinline__ void ret_stage_kv(const Ctx& F, const Ptrs& P, size_t row0, int h) {
#pragma unroll
    for (int i = 0; i < 4; ++i) { const int ch = F.tid + i * NTHR, r = ch >> 4, c = ch & 15;
        const v4u x = *(const GAS v4u*)(P.RK + (row0 + r) * 512 + h * 128 + c * 8); *(LAS v4u*)(F.lds + KIMG + r * KS_ + c * 16) = x; }
#pragma unroll
    for (int i = 0; i < 8; ++i) { const int ch = F.tid + i * NTHR, r = ch >> 5, c = ch & 31;
        const v4u x = *(const GAS v4u*)(P.RV + (row0 + r) * 1024 + h * 256 + c * 8); *(LAS v4u*)(F.lds + VIMG + r * VS_ + c * 16) = x; }
}
__device__ __forceinline__ void ph_ret_kv(const Ctx& F, const Ptrs& P) {
    const int lane = F.lane, w = F.wave, fr = lane & 15, fq = lane >> 4;
    v4u pk[4], pv[8];
#define RKV_PREFETCH(U) do { const int u_ = (U), c_ = u_ & 63, h_ = (u_ >> 6) & 3, b_ = u_ >> 8; const size_t r0_ = (size_t)b_ * T + (size_t)c_ * RCH; \
        _Pragma("unroll") for (int i = 0; i < 4; ++i) { const int ch = F.tid + i * NTHR, r = ch >> 4, c = ch & 15; pk[i] = *(const GAS v4u*)(P.RK + (r0_ + r) * 512 + h_ * 128 + c * 8); } \
        _Pragma("unroll") for (int i = 0; i < 8; ++i) { const int ch = F.tid + i * NTHR, r = ch >> 5, c = ch & 31; pv[i] = *(const GAS v4u*)(P.RV + (r0_ + r) * 1024 + h_ * 256 + c * 8); } } while (0)
    if ((int)blockIdx.x < 512) RKV_PREFETCH((int)blockIdx.x);
    for (int u = blockIdx.x; u < 512; u += F.G) {
        __syncthreads();
#pragma unroll
        for (int i = 0; i < 4; ++i) { const int ch = F.tid + i * NTHR, r = ch >> 4, c = ch & 15; *(LAS v4u*)(F.lds + KIMG + r * KS_ + c * 16) = pk[i]; }
#pragma unroll
        for (int i = 0; i < 8; ++i) { const int ch = F.tid + i * NTHR, r = ch >> 5, c = ch & 31; *(LAS v4u*)(F.lds + VIMG + r * VS_ + c * 16) = pv[i]; }
        if (u + F.G < 512) RKV_PREFETCH(u + F.G);
        asm volatile("s_waitcnt lgkmcnt(0)" ::: "memory"); __builtin_amdgcn_s_barrier(); asm volatile("" ::: "memory");
        f32x4 acc[2][8];
#pragma unroll
        for (int a = 0; a < 2; ++a)
#pragma unroll
            for (int d = 0; d < 8; ++d) acc[a][d] = (f32x4){0.f, 0.f, 0.f, 0.f};
#pragma unroll
        for (int ks = 0; ks < 4; ++ks) {
            bf16x8 xv[2];
#pragma unroll
            for (int a = 0; a < 2; ++a) xv[a] = tr_frag(F.lds + VIMG, VS_, 32 * ks, 32 * ks + 16, 16 * (2 * w + a), lane);
            bf16x8 yk[8];
#pragma unroll
            for (int d = 0; d < 8; ++d) yk[d] = tr_frag(F.lds + KIMG, KS_, 32 * ks, 32 * ks + 16, 16 * d, lane);
#pragma unroll
            for (int d = 0; d < 8; ++d)
#pragma unroll
                for (int a = 0; a < 2; ++a) acc[a][d] = mfma16(xv[a], yk[d], acc[a][d]);
        }
        float* o = P.KVC + (size_t)u * 32768;
#pragma unroll
        for (int a = 0; a < 2; ++a)
#pragma unroll
            for (int d = 0; d < 8; ++d)
#pragma unroll
                for (int r = 0; r < 4; ++r) o[(size_t)(16 * (2 * w + a) + 4 * fq + r) * 128 + 16 * d + fr] = acc[a][d][r];
    }
#undef RKV_PREFETCH
}
__device__ __forceinline__ void ph_ret_scan(const Ctx& F, const Ptrs& P, int layer, int vb, int VG) {
    bf16* SCT = (bf16*)P.SC;
    for (int i = vb * NTHR + F.tid; i < 8 * 16384; i += VG * NTHR) {
        const int bh = i >> 14, e = (i & 16383) * 2, h = bh & 3; const float lg = log_gamma_h(h), g128 = __expf(128.f * lg), g127 = __expf(127.f * lg);
        float s0 = 0.f, s1 = 0.f;
#pragma unroll 1
        for (int c0 = 0; c0 < NCH; c0 += 32) { f32x2s kv[32];
#pragma unroll
            for (int j = 0; j < 32; ++j) kv[j] = *(const GAS f32x2s*)(P.KVC + ((size_t)bh * 64 + c0 + j) * 32768 + e);
#pragma unroll
            for (int j = 0; j < 32; ++j) { const size_t o = ((size_t)bh * 64 + c0 + j) * 32768 + e;
                *(GAS unsigned*)(SCT + o) = pk2(s0, s1); s0 = s0 * g128 + g127 * kv[j].x; s1 = s1 * g128 + g127 * kv[j].y; } }
        const int v = e >> 7, d = e & 127; float* pr = P.out + O_PRET + ((size_t)layer * 8 + bh) * 32768;
        pr[(size_t)d * 256 + v] = s0; pr[(size_t)(d + 1) * 256 + v] = s1;
    }
}
constexpr int S0IMG = 128 * KS_;
static_assert(S0IMG + 256 * KS_ <= RING_BYTES && VIMG == S0IMG, "retention output LDS images");
__device__ __forceinline__ void ph_ret_out(const Ctx& F, const Ptrs& P) {
    const bf16* SCT = (const bf16*)P.SC;
    const int lane = F.lane, fr = lane & 15, fq = lane >> 4;
    for (int u = blockIdx.x; u < 512; u += F.G) {
        int w = F.wave; asm volatile("" : "+s"(w));
        const int c = u & 63, h = (u >> 6) & 3, b = u >> 8; const size_t row0 = (size_t)b * T + (size_t)c * RCH;
        const float gam = 1.f - exp2f(-5.f - (float)h);
        const bf16* st = SCT + (size_t)u * 32768;
        __syncthreads();
#pragma unroll
        for (int i = 0; i < 4; ++i) { const int ch = F.tid + i * NTHR, r = ch >> 4, cc = ch & 15;
            const v4u x = *(const GAS v4u*)(P.RK + (row0 + r) * 512 + h * 128 + cc * 8); *(LAS v4u*)(F.lds + KIMG + r * KS_ + cc * 16) = x; }
#pragma unroll
        for (int i = 0; i < 8; ++i) { const int ch = F.tid + i * NTHR, r = ch >> 4, cc = ch & 15;
            const v4u x = *(const GAS v4u*)(st + (size_t)r * 128 + cc * 8); *(LAS v4u*)(F.lds + S0IMG + r * KS_ + cc * 16) = x; }
        v4u vreg[8];
#pragma unroll
        for (int i = 0; i < 8; ++i) { const int ch = F.tid + i * NTHR, r = ch >> 5, cc = ch & 31; vreg[i] = *(const GAS v4u*)(P.RV + (row0 + r) * 1024 + h * 256 + cc * 8); }
        bf16x8 yq[4];
#pragma unroll
        for (int ks = 0; ks < 4; ++ks) yq[ks] = *(const GAS bf16x8*)(P.RQ + (row0 + 16 * w + fr) * 512 + h * 128 + 32 * ks + 8 * fq);
        __syncthreads();
        f32x4 acc[16];
#pragma unroll
        for (int v0 = 0; v0 < 16; v0 += 4) { bf16x8 xs[4][4];
#pragma unroll
            for (int j = 0; j < 4; ++j)
#pragma unroll
                for (int ks = 0; ks < 4; ++ks) xs[j][ks] = *(const LAS bf16x8*)(F.lds + S0IMG + (16 * (v0 + j) + fr) * KS_ + (32 * ks + 8 * fq) * 2);
#pragma unroll
            for (int j = 0; j < 4; ++j) { f32x4 a = (f32x4){0.f, 0.f, 0.f, 0.f};
#pragma unroll
                for (int ks = 0; ks < 4; ++ks) a = mfma16(xs[j][ks], yq[ks], a);
                acc[v0 + j] = a * gam; }
            asm volatile("" ::: "memory"); }
        bf16x8 pf[4];
#pragma unroll
        for (int pp = 0; pp < 4; ++pp) {
            unsigned pk[4] = {0u, 0u, 0u, 0u};
#pragma unroll
            for (int hh = 0; hh < 2; ++hh) { const int jt = 2 * pp + hh;
                if (jt <= w) { f32x4 d4 = (f32x4){0.f, 0.f, 0.f, 0.f};
                    bf16x8 xk[4];
#pragma unroll
                    for (int ks = 0; ks < 4; ++ks) xk[ks] = *(const LAS bf16x8*)(F.lds + KIMG + (16 * jt + fr) * KS_ + (32 * ks + 8 * fq) * 2);
#pragma unroll
                    for (int ks = 0; ks < 4; ++ks) d4 = mfma16(xk[ks], yq[ks], d4);
                    if (jt == w) {
#pragma unroll
                        for (int r = 0; r < 4; ++r) d4[r] = (4 * fq + r <= fr) ? d4[r] : 0.f; }
                    pk[2 * hh] = pk2(d4[0], d4[1]); pk[2 * hh + 1] = pk2(d4[2], d4[3]); } }
            pf[pp] = __builtin_bit_cast(bf16x8, (v4u){pk[0], pk[1], pk[2], pk[3]});
        }
        __syncthreads();
#pragma unroll
        for (int i = 0; i < 8; ++i) { const int ch = F.tid + i * NTHR, r = ch >> 5, cc = ch & 31; *(LAS v4u*)(F.lds + VIMG + r * VS_ + cc * 16) = vreg[i]; }
        __syncthreads();
#pragma unroll
        for (int pp = 0; pp < 4; ++pp) if (2 * pp <= w) {
#pragma unroll
            for (int v0 = 0; v0 < 16; v0 += 8) { bf16x8 xv[8];
#pragma unroll
                for (int j = 0; j < 8; ++j) xv[j] = tr_frag(F.lds + VIMG, VS_, 32 * pp, 32 * pp + 16, 16 * (v0 + j), lane);
#pragma unroll
                for (int j = 0; j < 8; ++j) acc[v0 + j] = mfma16(xv[j], pf[pp], acc[v0 + j]);
                asm volatile("" ::: "memory"); } }
        const size_t ob = (row0 + 16 * w + fr) * 1024 + h * 256 + 4 * fq;
        u32x2v gwv[16];
#pragma unroll
        for (int vt = 0; vt < 16; ++vt) gwv[vt] = *(const GAS u32x2v*)(P.RG + ob + 16 * vt);
        float s1 = 0.f;
#pragma unroll
        for (int vt = 0; vt < 16; ++vt) s1 += (acc[vt][0] + acc[vt][1]) + (acc[vt][2] + acc[vt][3]);
        s1 += __shfl_xor(s1, 16); s1 += __shfl_xor(s1, 32);
        const float mu = s1 * (1.f / 256.f); float s2 = 0.f;
#pragma unroll
        for (int vt = 0; vt < 16; ++vt) { const f32x4 dd = acc[vt] - mu; s2 += (dd[0] * dd[0] + dd[1] * dd[1]) + (dd[2] * dd[2] + dd[3] * dd[3]); }
        s2 += __shfl_xor(s2, 16); s2 += __shfl_xor(s2, 32);
        const float rstd = 1.f / sqrtf(s2 * (1.f / 256.f) + GN_EPS);
#pragma unroll
        for (int vt = 0; vt < 16; ++vt) { const f32x4 o = (acc[vt] - mu) * rstd; u32x2v ww; const u32x2v gw = gwv[vt];
            ww.x = pk2(o[0] * bf2f((bf16)(gw.x & 0xffff)), o[1] * bf2f((bf16)(gw.x >> 16))); ww.y = pk2(o[2] * bf2f((bf16)(gw.y & 0xffff)), o[3] * bf2f((bf16)(gw.y >> 16)));
            *(GAS u32x2v*)(P.RO + ob + 16 * vt) = ww; }
    }
}
__device__ __forceinline__ void ph_ret_sample(const Ctx& F, const Ptrs& P, int layer) {
    LAS float* qk = (LAS float*)(F.lds);
    LAS float* po = (LAS float*)(F.lds + 4096);
    LAS float* red = (LAS float*)(F.lds + 4096 + 8192);
    const int t = F.tid & 255, half = F.tid >> 8, v4 = (t & 63) * 4, dq = t >> 6;
    for (int it0 = blockIdx.x * 2; it0 < NS * RH; it0 += F.G * 2) {
        const int it = it0 + half, n = it >> 2, h = it & 3; const size_t m = (size_t)MPR + n;
        const float gam = 1.f - exp2f(-5.f - (float)h);
        const float* s0 = P.state + (((size_t)layer * NS + n) * RH + h) * 32768 + (size_t)(32 * dq) * 256 + v4;
        float* s1o = P.out + O_SRET + (((size_t)layer * NS + n) * RH + h) * 32768 + (size_t)(32 * dq) * 256 + v4;
        __syncthreads();
        const bf16 qkv = (t < 128) ? P.RK[m * 512 + h * 128 + t] : P.RQ[m * 512 + h * 128 + (t - 128)];
        const u32x2v vw = *(const GAS u32x2v*)(P.RV + m * 1024 + h * 256 + v4);
        f32x4 x[16];
#pragma unroll
        for (int d = 0; d < 16; ++d) x[d] = __builtin_nontemporal_load((const f32x4*)(s0 + (size_t)d * 256));
        qk[half * 256 + t] = bf2f(qkv);
        const f32x4 vv = (f32x4){bf2f((bf16)(vw.x & 0xffff)), bf2f((bf16)(vw.x >> 16)), bf2f((bf16)(vw.y & 0xffff)), bf2f((bf16)(vw.y >> 16))};
        asm volatile("s_waitcnt lgkmcnt(0)" ::: "memory"); __builtin_amdgcn_s_barrier(); asm volatile("" ::: "memory");
        f32x4 o = (f32x4){0.f, 0.f, 0.f, 0.f};
#pragma unroll 1
        for (int d0 = 0; d0 < 32; d0 += 16) {
            if (d0) {
#pragma unroll
                for (int d = 0; d < 16; ++d) x[d] = __builtin_nontemporal_load((const f32x4*)(s0 + (size_t)(d0 + d) * 256)); }
#pragma unroll
            for (int d = 0; d < 16; ++d) { const int dd = 32 * dq + d0 + d; const f32x4 s1 = x[d] * gam + vv * qk[half * 256 + dd]; __builtin_nontemporal_store(s1, (f32x4*)(s1o + (size_t)(d0 + d) * 256)); o += s1 * qk[half * 256 + 128 + dd]; }
        }
        *(LAS f32x4*)(po + (half * 4 + dq) * 256 + v4) = o;
        __syncthreads();
        const float ov = (po[(half * 4 + 0) * 256 + t] + po[(half * 4 + 1) * 256 + t]) + (po[(half * 4 + 2) * 256 + t] + po[(half * 4 + 3) * 256 + t]);
        float s = wave_sum(ov); if ((t & 63) == 0) red[half * 16 + (t >> 6)] = s; __syncthreads();
        const float mu = (red[half * 16 + 0] + red[half * 16 + 1] + red[half * 16 + 2] + red[half * 16 + 3]) * (1.f / 256.f);
        const float dd = ov - mu; float q = wave_sum(dd * dd); if ((t & 63) == 0) red[half * 16 + 4 + (t >> 6)] = q; __syncthreads();
        const float rstd = 1.f / sqrtf((red[half * 16 + 4] + red[half * 16 + 5] + red[half * 16 + 6] + red[half * 16 + 7]) * (1.f / 256.f) + GN_EPS);
        P.RO[m * 1024 + h * 256 + t] = (bf16)f2bf(dd * rstd * bf2f(P.RG[m * 1024 + h * 256 + t]));
    }
}
constexpr float LOG2E = 1.4426950408889634f;
constexpr int AKS_ = 160, AKIMG = 0, AVIMG = 256 * AKS_, AV_ROWS = 272;
static_assert(AVIMG + AV_ROWS * AKS_ <= RING_BYTES, "attention LDS images");
__device__ __forceinline__ float alibi_pen(int g, int h) { return exp2f(-8.f * (float)(g * 4 + h + 1) / 12.f) * (float)(1 << (2 * g)) * LOG2E; }
__device__ __forceinline__ void ph_attn_prompt(const Ctx& F, const Ptrs& P, bf16* OG, float* LSEB) {
    const int lane = F.lane, w = F.wave, fr = lane & 15, fq = lane >> 4, i0 = 16 * w;
    v4u pfk[4], pfv[4]; bf16x8 pfq[2];
#define ATTN_PREFETCH(UN) do { const int un_ = (UN), ub_ = un_ & 63, h_ = (un_ >> 6) & 3, g_ = (un_ >> 8) % 3, b_ = un_ / 768, dsh_ = 2 * g_, dil_ = 1 << dsh_, r_ = ub_ & (dil_ - 1), nb_ = ub_ >> dsh_; \
        const size_t rowb_ = (size_t)b_ * T; const int col_ = g_ * 256 + h_ * 64; \
        _Pragma("unroll") for (int i = 0; i < 4; ++i) { const int ch = F.tid + i * NTHR, kk = ch >> 3, c = ch & 7, l_ = 128 * (nb_ - 1) + kk; unsigned z0 = 0u; asm volatile("" : "+v"(z0)); \
            pfk[i] = (v4u){z0, z0, z0, z0}; pfv[i] = pfk[i]; \
            if (l_ >= 0) { const size_t row = rowb_ + (size_t)l_ * dil_ + r_; pfk[i] = *(const GAS v4u*)(P.AK + row * 768 + col_ + c * 8); pfv[i] = *(const GAS v4u*)(P.AV + row * 768 + col_ + c * 8); } } \
        const size_t qrow_ = rowb_ + (size_t)(128 * nb_ + i0 + fr) * dil_ + r_; \
        _Pragma("unroll") for (int ks = 0; ks < 2; ++ks) pfq[ks] = *(const GAS bf16x8*)(P.AQ + qrow_ * 768 + col_ + 32 * ks + 8 * fq); } while (0)
    if ((int)blockIdx.x < NB * 3 * AH * 64) ATTN_PREFETCH((int)blockIdx.x);
    for (int un = blockIdx.x; un < NB * 3 * AH * 64; un += F.G) {
        const int ub = un & 63, h = (un >> 6) & 3, g = (un >> 8) % 3, b = un / 768;
        const int dsh = 2 * g, dil = 1 << dsh, r = ub & (dil - 1), nb = ub >> dsh;
        const size_t rowb = (size_t)b * T; const int col = g * 256 + h * 64;
        __syncthreads();
#pragma unroll
        for (int i = 0; i < 4; ++i) { const int ch = F.tid + i * NTHR, kk = ch >> 3, c = ch & 7;
            *(LAS v4u*)(F.lds + AKIMG + kk * AKS_ + c * 16) = pfk[i]; *(LAS v4u*)(F.lds + AVIMG + kk * AKS_ + c * 16) = pfv[i]; }
        if (F.tid < 128) { const int kk = 256 + (F.tid >> 3), c = F.tid & 7; unsigned z1 = 0u; asm volatile("" : "+v"(z1)); *(LAS v4u*)(F.lds + AVIMG + kk * AKS_ + c * 16) = (v4u){z1, z1, z1, z1}; }
        const size_t qrow = rowb + (size_t)(128 * nb + i0 + fr) * dil + r;
        bf16x8 yq[2] = {pfq[0], pfq[1]};
        if (un + F.G < NB * 3 * AH * 64) ATTN_PREFETCH(un + F.G);
        const float pen = alibi_pen(g, h);
        asm volatile("s_waitcnt lgkmcnt(0)" ::: "memory"); __builtin_amdgcn_s_barrier(); asm volatile("" ::: "memory");
        f32x4 sc[9]; float mx = -INFINITY;
        bf16x8 xk[9][2];
#pragma unroll
        for (int kt = 0; kt < 9; ++kt)
#pragma unroll
            for (int ks = 0; ks < 2; ++ks) xk[kt][ks] = *(const LAS bf16x8*)(F.lds + AKIMG + (i0 + 16 * kt + fr) * AKS_ + (32 * ks + 8 * fq) * 2);
#pragma unroll
        for (int kt = 0; kt < 9; ++kt) { f32x4 d4 = (f32x4){0.f, 0.f, 0.f, 0.f};
#pragma unroll
            for (int ks = 0; ks < 2; ++ks) d4 = mfma16(xk[kt][ks], yq[ks], d4);
#pragma unroll
            for (int rr = 0; rr < 4; ++rr) { const int dist = fr + 128 - 16 * kt - 4 * fq - rr; const bool ok = dist >= 0 && dist <= 128 && (nb > 0 || i0 + 16 * kt + 4 * fq + rr >= 128);
                d4[rr] = ok ? d4[rr] - pen * (float)dist : -INFINITY; mx = fmaxf(mx, d4[rr]); }
            sc[kt] = d4; }
        mx = fmaxf(mx, __shfl_xor(mx, 16)); mx = fmaxf(mx, __shfl_xor(mx, 32));
        float ls = 0.f; bf16x8 pf[5];
#pragma unroll
        for (int pp = 0; pp < 5; ++pp) { unsigned pk[4] = {0u, 0u, 0u, 0u};
#pragma unroll
            for (int hh = 0; hh < 2; ++hh) { const int kt = 2 * pp + hh;
                if (kt < 9) { f32x4 p4;
#pragma unroll
                    for (int rr = 0; rr < 4; ++rr) { p4[rr] = __builtin_amdgcn_exp2f(sc[kt][rr] - mx); ls += p4[rr]; }
                    pk[2 * hh] = pk2(p4[0], p4[1]); pk[2 * hh + 1] = pk2(p4[2], p4[3]); } }
            pf[pp] = __builtin_bit_cast(bf16x8, (v4u){pk[0], pk[1], pk[2], pk[3]}); }
        ls += __shfl_xor(ls, 16); ls += __shfl_xor(ls, 32);
        f32x4 oa[4];
#pragma unroll
        for (int d0 = 0; d0 < 4; d0 += 2) { bf16x8 xv[2][5];
#pragma unroll
            for (int j = 0; j < 2; ++j)
#pragma unroll
                for (int pp = 0; pp < 5; ++pp) xv[j][pp] = tr_frag(F.lds + AVIMG, AKS_, i0 + 32 * pp, i0 + 32 * pp + 16, 16 * (d0 + j), lane);
#pragma unroll
            for (int j = 0; j < 2; ++j) { f32x4 a = (f32x4){0.f, 0.f, 0.f, 0.f};
#pragma unroll
                for (int pp = 0; pp < 5; ++pp) a = mfma16(xv[j][pp], pf[pp], a);
                oa[d0 + j] = a; } }
        const float inv = 1.f / ls;
        bf16* og = OG + ((size_t)g * MP + qrow) * 256 + h * 64 + 4 * fq;
#pragma unroll
        for (int dt = 0; dt < 4; ++dt) { u32x2v ww; ww.x = pk2(oa[dt][0] * inv, oa[dt][1] * inv); ww.y = pk2(oa[dt][2] * inv, oa[dt][3] * inv); *(GAS u32x2v*)(og + 16 * dt) = ww; }
        if (fq == 0) LSEB[((size_t)g * MP + qrow) * 4 + h] = mx + __builtin_amdgcn_logf(ls);
    }
}
#undef ATTN_PREFETCH
__device__ __forceinline__ void ph_attn_sample(const Ctx& F, const Ptrs& P, bf16* OG, float* LSEB, int layer) {
    const float* const pc0 = P.c0; const float* const pc1 = P.c1; const float* const pc2 = P.c2;
    LAS float* cmb = (LAS float*)F.lds;
    const int lane = F.lane, w = F.wave, hh = lane >> 4, dd = (lane & 15) * 4;
    for (int un = blockIdx.x; un < NS * 3; un += F.G) {
        const int n = un / 3, g = un % 3, dil = 1 << (2 * g), wlen = 128 * dil; const size_t m = (size_t)MPR + n;
        const float* cb = ((g == 0) ? pc0 : (g == 1 ? pc1 : pc2)) + ((size_t)layer * NS + n) * wlen * 512 + hh * 64 + dd;
        const float pen = alibi_pen(g, hh);
        f32x4 q4; { const u32x2v qw = *(const GAS u32x2v*)(P.AQ + m * 768 + g * 256 + hh * 64 + dd); q4 = (f32x4){bf2f((bf16)(qw.x & 0xffff)), bf2f((bf16)(qw.x >> 16)), bf2f((bf16)(qw.y & 0xffff)), bf2f((bf16)(qw.y >> 16))}; }
        float mx = -INFINITY, ls = 0.f; f32x4 o4 = (f32x4){0.f, 0.f, 0.f, 0.f};
        u32x2v kw = (u32x2v){0u, 0u}, vw = kw;
        if (w == 0) { kw = *(const GAS u32x2v*)(P.AK + m * 768 + g * 256 + hh * 64 + dd); vw = *(const GAS u32x2v*)(P.AV + m * 768 + g * 256 + hh * 64 + dd); }
        {
            f32x4 k4[16], v4[16];
#pragma unroll
            for (int jj = 0; jj < 16; ++jj) { const int j = 16 * w + 1 + jj; const float* rp = cb + (size_t)(wlen - dil * j) * 512;
                k4[jj] = __builtin_nontemporal_load((const f32x4*)rp); v4[jj] = __builtin_nontemporal_load((const f32x4*)(rp + 256)); }
#pragma unroll
            for (int jj = 0; jj < 16; ++jj) { const int j = 16 * w + 1 + jj;
                float s = (q4[0] * k4[jj][0] + q4[1] * k4[jj][1]) + (q4[2] * k4[jj][2] + q4[3] * k4[jj][3]);
                s += __shfl_xor(s, 1); s += __shfl_xor(s, 2); s += __shfl_xor(s, 4); s += __shfl_xor(s, 8);
                s -= pen * (float)j;
                const float mn = fmaxf(mx, s), corr = __builtin_amdgcn_exp2f(mx - mn), p = __builtin_amdgcn_exp2f(s - mn);
                ls = ls * corr + p; mx = mn; o4 = o4 * corr + v4[jj] * p; }
        }
        if (w == 0) {
            float s = q4[0] * bf2f((bf16)(kw.x & 0xffff)) + q4[1] * bf2f((bf16)(kw.x >> 16)) + q4[2] * bf2f((bf16)(kw.y & 0xffff)) + q4[3] * bf2f((bf16)(kw.y >> 16));
            s += __shfl_xor(s, 1); s += __shfl_xor(s, 2); s += __shfl_xor(s, 4); s += __shfl_xor(s, 8);
            const float mn = fmaxf(mx, s), corr = __builtin_amdgcn_exp2f(mx - mn), p = __builtin_amdgcn_exp2f(s - mn);
            ls = ls * corr + p; mx = mn;
            o4 = o4 * corr + (f32x4){bf2f((bf16)(vw.x & 0xffff)), bf2f((bf16)(vw.x >> 16)), bf2f((bf16)(vw.y & 0xffff)), bf2f((bf16)(vw.y >> 16))} * p;
        }
        __syncthreads();
        { LAS float* c = cmb + (w * 64 + lane) * 6; c[0] = mx; c[1] = ls; c[2] = o4[0]; c[3] = o4[1]; c[4] = o4[2]; c[5] = o4[3]; }
        __syncthreads();
        if (w == 0) {
            float M = -INFINITY;
#pragma unroll
            for (int ww = 0; ww < 8; ++ww) M = fmaxf(M, cmb[(ww * 64 + lane) * 6]);
            float L = 0.f; f32x4 O = (f32x4){0.f, 0.f, 0.f, 0.f};
#pragma unroll
            for (int ww = 0; ww < 8; ++ww) { const LAS float* c = cmb + (ww * 64 + lane) * 6; const float f = __builtin_amdgcn_exp2f(c[0] - M); L += c[1] * f; O += (f32x4){c[2], c[3], c[4], c[5]} * f; }
            const float inv = 1.f / L;
            u32x2v ww2; ww2.x = pk2(O[0] * inv, O[1] * inv); ww2.y = pk2(O[2] * inv, O[3] * inv);
            *(GAS u32x2v*)(OG + ((size_t)g * MP + m) * 256 + hh * 64 + dd) = ww2;
            if ((lane & 15) == 0) LSEB[((size_t)g * MP + m) * 4 + hh] = M + __builtin_amdgcn_logf(L);
        }
    }
}
__device__ __forceinline__ void ph_attn_merge(const Ctx& F, const Ptrs& P, const bf16* OG, const float* LSEB, int vb, int VG) {
#pragma unroll 4
    for (int i = vb * NTHR + F.tid; i < MR * 32; i += VG * NTHR) {
        const int m = i >> 5, c = i & 31, h = c >> 3;
        const float l0 = LSEB[((size_t)0 * MP + m) * 4 + h], l1 = LSEB[((size_t)1 * MP + m) * 4 + h], l2 = LSEB[((size_t)2 * MP + m) * 4 + h];
        const float M = fmaxf(l0, fmaxf(l1, l2)); float w0 = __builtin_amdgcn_exp2f(l0 - M), w1 = __builtin_amdgcn_exp2f(l1 - M), w2 = __builtin_amdgcn_exp2f(l2 - M);
        const float inv = 1.f / (w0 + w1 + w2); w0 *= inv; w1 *= inv; w2 *= inv;
        const v4u a = *(const GAS v4u*)(OG + ((size_t)0 * MP + m) * 256 + c * 8), bq = *(const GAS v4u*)(OG + ((size_t)1 * MP + m) * 256 + c * 8), cq = *(const GAS v4u*)(OG + ((size_t)2 * MP + m) * 256 + c * 8);
        v4u o;
#pragma unroll
        for (int j = 0; j < 4; ++j) { const unsigned x = a[j], y = bq[j], z = cq[j];
            const float lo = w0 * bf2f((bf16)(x & 0xffff)) + w1 * bf2f((bf16)(y & 0xffff)) + w2 * bf2f((bf16)(z & 0xffff));
            const float hi = w0 * bf2f((bf16)(x >> 16)) + w1 * bf2f((bf16)(y >> 16)) + w2 * bf2f((bf16)(z >> 16));
            o[j] = pk2(lo, hi); }
        *(GAS v4u*)(P.AO + (size_t)m * 256 + c * 8) = o;
    }
}

template <int NT, int NC, int MT, int KB, class Epi>
__device__ __forceinline__ void small_gemm_r(const Ctx& F, const bf16* A, const bf16* Bt, int N, int K, const Epi& E, int vb, int nbk, int it0, int it1);
template <int NT, int NC, int MT, int KB, class Epi>
__device__ __forceinline__ void small_gemm(const Ctx& F, const bf16* A, const bf16* Bt, int N, int K, const Epi& E, int first_block = 0) {
    const int nitems = ((NT == 1) ? N / (16 * NC) : N / 32) * (8 / MT);
    small_gemm_r<NT, NC, MT, KB, Epi>(F, A, Bt, N, K, E, (int)blockIdx.x - first_block, (int)gridDim.x - first_block, 0, nitems);
}
template <int NT, int NC, int MT, int KB, class Epi>
__device__ __forceinline__ void small_gemm_r(const Ctx& F, const bf16* A, const bf16* Bt, int N, int K, const Epi& E, int vb, int nbk, int it0, int it1) {
    LAS f32x4* red = (LAS f32x4*)F.lds;
    const int lane = F.lane, w = F.wave, fr = lane & 15, fq = lane >> 4;
    constexpr int RP = 8 / MT;
    const int ksw = K / 32 / (8 / NT), kw = (NT == 1) ? w : (w & 3);
    if (vb < 0 || vb >= nbk) return;
    for (int it = it0 + nbk - 1 - vb; it < it1; it += nbk) {
        const int ct = it / RP, rh = it % RP;
        int brow;
        if (NT == 1) brow = 16 * NC * ct; else { const int j0 = 16 * ct; brow = 256 * (j0 >> 7) + (j0 & 127) + ((w >> 2) ? 128 : 0); }
        f32x4 acc[NC][MT];
#pragma unroll
        for (int c = 0; c < NC; ++c)
#pragma unroll
            for (int mt = 0; mt < MT; ++mt) acc[c][mt] = (f32x4){0.f, 0.f, 0.f, 0.f};
        const bf16* bp = Bt + (size_t)(brow + fr) * K + 8 * fq + 32 * (kw * ksw); const bf16* ap = A + (size_t)(16 * MT * rh + fr) * K + 8 * fq + 32 * (kw * ksw);
#pragma unroll 1
        for (int k0 = 0; k0 < ksw; k0 += KB) {
            bf16x8 yb[KB][NC], xa[KB][MT];
#pragma unroll
            for (int j = 0; j < KB; ++j) if (k0 + j < ksw) {
#pragma unroll
                for (int c = 0; c < NC; ++c) yb[j][c] = *(const GAS bf16x8*)(bp + (size_t)(16 * c) * K + 32 * (k0 + j));
#pragma unroll
                for (int mt = 0; mt < MT; ++mt) xa[j][mt] = *(const GAS bf16x8*)(ap + (size_t)(16 * mt) * K + 32 * (k0 + j)); }
#pragma unroll
            for (int j = 0; j < KB; ++j) if (k0 + j < ksw) {
#pragma unroll
                for (int c = 0; c < NC; ++c)
#pragma unroll
                    for (int mt = 0; mt < MT; ++mt) acc[c][mt] = mfma16(yb[j][c], xa[j][mt], acc[c][mt]); }
        }
        __syncthreads();
#pragma unroll
        for (int c = 0; c < NC; ++c)
#pragma unroll
            for (int mt = 0; mt < MT; ++mt) red[((w * NC + c) * MT + mt) * 64 + lane] = acc[c][mt];
        __syncthreads();
        if (w < MT) {
            if constexpr (NT == 1) {
#pragma unroll
                for (int c = 0; c < NC; ++c) { f32x4 v = red[((0 * NC + c) * MT + w) * 64 + lane];
#pragma unroll
                    for (int ww = 1; ww < 8; ++ww) v += red[((ww * NC + c) * MT + w) * 64 + lane];
                    E.small(16 * MT * rh + 16 * w + fr, 16 * (NC * ct + c) + 4 * fq, v); }
            } else { f32x4 g = red[(0 * MT + w) * 64 + lane], up = red[(4 * MT + w) * 64 + lane];
#pragma unroll
                for (int ww = 1; ww < 4; ++ww) { g += red[(ww * MT + w) * 64 + lane]; up += red[((4 + ww) * MT + w) * 64 + lane]; }
                E.small2(16 * MT * rh + 16 * w + fr, 16 * ct + 4 * fq, g, up);
            }
        }
    }
}
__device__ __forceinline__ int stage_rs(LAS unsigned char* L, const float* ssp, int wave0, int tail_pm = -1) {
    if ((int)gridDim.x != 256) return -1;
    const int row0 = 2048 * ((int)blockIdx.x & 7), t = wave0 * 64 + lane_id();
    LAS float* tab = (LAS float*)(L + pg8::RS_LDS_OFF);
#pragma unroll
    for (int i = 0; i < 4; ++i) tab[t + i * NTHR] = __builtin_amdgcn_rsqf(ssp[row0 + t + i * NTHR] * (1.f / DM) + RMS_EPS);
    if (tail_pm >= 0 && t < 256) tab[pg8::RS_LDS_ROWS + t] = __builtin_amdgcn_rsqf(ssp[tail_pm * 256 + t] * (1.f / DM) + RMS_EPS);
    __syncthreads();
    return row0;
}
#ifndef SKIP
#define SKIP 0
#endif
#define ON(b) (!((SKIP >> (b)) & 1))
#ifndef REPM
#define REPM 0
#endif
#ifndef REPX
#define REPX 2
#endif
#define NREP(b) (1 + (((REPM) >> (b)) & 1) * (REPX))
#ifndef MREP
#define MREP 0
#endif
#define MR_(b) for (int mr_ = 0; mr_ < 1 + ((MREP >> (b)) & 1) * 2; ++mr_)
#ifndef SREP
#define SREP 0
#endif
#define REPEAT(b) for (int rep_ = 0; rep_ < NREP(b); ++rep_)
#define REPBAR(b) do { if (rep_ + 1 < NREP(b)) xcd_barrier(bar); } while (0)
constexpr int PH_PER_LAYER = 9, N_PHASES = 2 + DEPTH * PH_PER_LAYER;
__global__ void __launch_bounds__(NTHR, 2) fwd(Args args) {
    extern __shared__ __attribute__((aligned(16))) unsigned char lds[];
    LAS unsigned char* const L = (LAS unsigned char*)lds;
    const int wave0 = __builtin_amdgcn_readfirstlane((int)(threadIdx.x >> 6));
    for (int u = threadIdx.x; u < (LDS_BYTES - LDSCTL_OFF) / 4; u += NTHR) ((LAS unsigned*)(L + LDSCTL_OFF))[u] = 0u;
    __syncthreads();
    gu32* ctl = (gu32*)(args.ws + WS_CTL);
    XcdBarrier bar = xcd_barrier_post((unsigned*)(ctl + CW_BAR), (volatile LAS unsigned*)(L + MISC_OFF) + 8);
    const int lo = args.ph_lo, hi = args.ph_hi;
#define IN(k) (lo <= (k) && (k) < hi)
#define SEAM(k) do { if (IN(k) && IN((k) + 1)) xcd_barrier(bar); } while (0)
    REPEAT(0) { if (IN(0) && ON(0)) { const Ptrs P = late_ptrs(); const Ctx F = make_ctx(L, wave0); ph_prologue(F, P); } REPBAR(0); } SEAM(0);
    for (int l = 0; l < DEPTH; ++l) {
        const int pb = 1 + l * PH_PER_LAYER;
        REPEAT(1) { if (IN(pb + 0) && ON(1)) {
            const Ptrs P = late_ptrs(); unsigned char* wl = P.ws + WS_W + (size_t)l * W_LAYER; const bf16* XB = (const bf16*)(P.ws + WS_XB);
            pg8::Gemm g{XB, (const bf16*)(wl + W_IN), MPR, DIN, DM};
            int gd_ = (int)gridDim.x, cb = (int)blockIdx.x; asm volatile("" : "+s"(gd_), "+s"(cb));     const bool g256 = gd_ == 256; const bool odd = cb & 1;
            int tpm; { pg8::StaticOrder S0; S0.init(MPR, DIN, gd_, cb, 0, g256 ? 1 : 0); tpm = S0.tail_pm(); }
            const float* ssp = (const float*)(P.ws + WS_SSP) + (size_t)(2 * l) * MPR; const int rs0 = stage_rs(L, ssp, wave0, tpm);
            pg8::EpiProj E{P.ws, P.out, l, ssp, (const float*)(P.ws + WS_SSS) + (2 * l) * NS, rs0};
            if (g256) { if (odd) small_gemm_r<1, 2, 4, 4>(make_ctx(L, wave0), XB + (size_t)MPR * DM, (const bf16*)(wl + W_IN), DIN, DM, E, cb >> 1, 128, 0, 256); __syncthreads(); }
            pg8::StaticOrder S; S.init(MPR, DIN, gd_, cb, 0, g256 ? 1 : 0);
            pg8::gemm_phase<pg8::EpiProj, pg8::StaticOrder, true, true>(L, g, S, E, wave0);
            if (g256) { if (!odd && cb >= 128) small_gemm_r<1, 2, 4, 4>(make_ctx(L, wave0), XB + (size_t)MPR * DM, (const bf16*)(wl + W_IN), DIN, DM, E, (cb - 128) >> 1, 64, 256, (DIN / 32) * 2); }
            else small_gemm<1, 2, 4, 4>(make_ctx(L, wave0), XB + (size_t)MPR * DM, (const bf16*)(wl + W_IN), DIN, DM, E, 0);
            __syncthreads();
            if (l == 0 && (g256 ? odd : cb >= 64)) { const Ctx F = make_ctx(L, wave0);
                if (g256) convert_weights(F, P, I_IN, DEPTH * I_LAYER, (cb >> 1) * NWAVES + F.wave, 128 * NWAVES); else convert_weights(F, P, I_IN, DEPTH * I_LAYER, (cb - 64) * NWAVES + F.wave, ((int)gridDim.x - 64) * NWAVES); }
        } REPBAR(1); } SEAM(pb + 0);
        REPEAT(2) { if (IN(pb + 1)) { const Ptrs P = late_ptrs(); bf16* OG = (bf16*)(P.ws + WS_OG); float* LSEB = (float*)(P.ws + WS_LSE);
#pragma unroll 1
            for (int pass = 0; pass < 2; ++pass) {
                if (((pass ^ (int)blockIdx.x) & 1) == 0) { MR_(0) { ph_ret_sample(make_ctx(L, wave0), P, l); __syncthreads(); } MR_(1) { ph_attn_sample(make_ctx(L, wave0), P, OG, LSEB, l); __syncthreads(); } }
                else { MR_(3) { ph_attn_prompt(make_ctx(L, wave0), P, OG, LSEB); __syncthreads(); } MR_(2) { ph_ret_kv(make_ctx(L, wave0), P); __syncthreads(); } }
                __syncthreads(); }
        } REPBAR(2); } SEAM(pb + 1);
        REPEAT(5) { if (IN(pb + 2) && ON(5)) { const Ptrs P = late_ptrs(); const Ctx F = make_ctx(L, wave0); ph_ret_scan(F, P, l, (int)blockIdx.x, (int)gridDim.x); ph_attn_merge(F, P, (const bf16*)(P.ws + WS_OG), (const float*)(P.ws + WS_LSE), (int)blockIdx.x, (int)gridDim.x); } REPBAR(5); } SEAM(pb + 2);
        REPEAT(6) { if (IN(pb + 3) && ON(6)) { const Ptrs P = late_ptrs(); const Ctx F = make_ctx(L, wave0); ph_ret_out(F, P); __syncthreads(); } REPBAR(6); }
        REPEAT(7) { if (IN(pb + 4) && ON(7)) {
            const Ptrs P = late_ptrs(); unsigned char* wl = P.ws + WS_W + (size_t)l * W_LAYER;
            pg8::Gemm g{P.AO, (const bf16*)(wl + W_ATT), MPR, DM, 256}; pg8::StaticOrder S; S.init(MPR, DM, (int)gridDim.x, (int)blockIdx.x);
            pg8::EpiAbr E{P.ws};
            pg8::gemm_phase<pg8::EpiAbr, pg8::StaticOrder, true, true>(L, g, S, E, wave0);
            for (int sr_ = 0; sr_ <= SREP; ++sr_) { small_gemm<1, 1, 2, 1>(make_ctx(L, wave0), P.AO + (size_t)MPR * 256, (const bf16*)(wl + W_ATT), DM, 256, E); __syncthreads(); }
        } REPBAR(7); } SEAM(pb + 4);
        REPEAT(8) { if (IN(pb + 5) && ON(8)) {
            const Ptrs P = late_ptrs(); unsigned char* wl = P.ws + WS_W + (size_t)l * W_LAYER;
            pg8::Gemm g{P.RO, (const bf16*)(wl + W_RET), MPR, DM, DM}; pg8::StaticOrder S; S.init(MPR, DM, (int)gridDim.x, (int)blockIdx.x);
            pg8::EpiRbr E{P.ws};
            pg8::gemm_phase<pg8::EpiRbr, pg8::StaticOrder, true, true>(L, g, S, E, wave0);
            for (int sr_ = 0; sr_ <= SREP; ++sr_) { small_gemm<1, 1, 2, 4>(make_ctx(L, wave0), P.RO + (size_t)MPR * DM, (const bf16*)(wl + W_RET), DM, DM, E); __syncthreads(); }
        } REPBAR(8); } SEAM(pb + 5);
        if (IN(pb + 6) && ON(9)) {
            const Ptrs P = late_ptrs(); unsigned char* wl = P.ws + WS_W + (size_t)l * W_LAYER;
            pg8::Gemm g{P.MG, (const bf16*)(wl + W_OUT), MPR, DM, DM}; pg8::StaticOrder S; S.init(MPR, DM, (int)gridDim.x, (int)blockIdx.x);
            pg8::EpiResid E{(bf16*)(P.ws + WS_XB), (float*)(P.ws + WS_SSP) + (size_t)(2 * l + 1) * MPR, (float*)(P.ws + WS_SSS) + (2 * l + 1) * NS};
            pg8::gemm_phase<pg8::EpiResid, pg8::StaticOrder, true, true>(L, g, S, E, wave0);
            small_gemm<1, 1, 2, 4>(make_ctx(L, wave0), P.MG + (size_t)MPR * DM, (const bf16*)(wl + W_OUT), DM, DM, E);
        } SEAM(pb + 6);
        REPEAT(11) { if (IN(pb + 7) && ON(11)) {
            const Ptrs P = late_ptrs(); unsigned char* wl = P.ws + WS_W + (size_t)l * W_LAYER; const bf16* XB = (const bf16*)(P.ws + WS_XB);
            pg8::Gemm g{XB, (const bf16*)(wl + W_GU), MPR, 2 * DFF, DM};
            int gd_ = (int)gridDim.x, cb = (int)blockIdx.x; asm volatile("" : "+s"(gd_), "+s"(cb));     const bool g256 = gd_ == 256; const bool odd = cb & 1;
            int tpm; { pg8::StaticOrder S0; S0.init(MPR, 2 * DFF, gd_, cb, 0, g256 ? 1 : 0); tpm = S0.tail_pm(); }
            const float* ssp = (const float*)(P.ws + WS_SSP) + (size_t)(2 * l + 1) * MPR; const int rs0 = stage_rs(L, ssp, wave0, tpm);
            pg8::EpiSwiglu E{P.H, ssp, (const float*)(P.ws + WS_SSS) + (2 * l + 1) * NS, rs0};
            if (g256) { if (odd) small_gemm_r<2, 1, 4, 4>(make_ctx(L, wave0), XB + (size_t)MPR * DM, (const bf16*)(wl + W_GU), 2 * DFF, DM, E, cb >> 1, 128, 0, 256); __syncthreads(); }
            pg8::StaticOrder S; S.init(MPR, 2 * DFF, gd_, cb, 0, g256 ? 1 : 0);
            pg8::gemm_phase<pg8::EpiSwiglu, pg8::StaticOrder, true, true>(L, g, S, E, wave0);
            if (g256) { if (odd) small_gemm_r<2, 1, 4, 4>(make_ctx(L, wave0), XB + (size_t)MPR * DM, (const bf16*)(wl + W_GU), 2 * DFF, DM, E, cb >> 1, 128, 256, (2 * DFF / 32) * 2); }
            else small_gemm<2, 1, 4, 4>(make_ctx(L, wave0), XB + (size_t)MPR * DM, (const bf16*)(wl + W_GU), 2 * DFF, DM, E, 0);
            __syncthreads();
        } REPBAR(11); } SEAM(pb + 7);
        if (IN(pb + 8) && ON(12)) {
            const Ptrs P = late_ptrs(); unsigned char* wl = P.ws + WS_W + (size_t)l * W_LAYER;
            pg8::Gemm g{P.H, (const bf16*)(wl + W_DN), MPR, DM, DFF}; pg8::StaticOrder S; S.init(MPR, DM, (int)gridDim.x, (int)blockIdx.x);
            pg8::EpiResid E{(bf16*)(P.ws + WS_XB), (float*)(P.ws + WS_SSP) + (size_t)(2 * l + 2) * MPR, (float*)(P.ws + WS_SSS) + (2 * l + 2) * NS};
            pg8::gemm_phase<pg8::EpiResid, pg8::StaticOrder, true, true>(L, g, S, E, wave0);
            small_gemm<1, 1, 2, 11>(make_ctx(L, wave0), P.H + (size_t)MPR * DFF, (const bf16*)(wl + W_DN), DM, DFF, E);
        } SEAM(pb + 8);
    }
    REPEAT(13) { if (IN(N_PHASES - 1) && ON(13)) { const Ptrs P = late_ptrs(); const Ctx F = make_ctx(L, wave0); ph_final_norm(F, P); } REPBAR(13); }
#undef IN
#undef SEAM
}

#ifndef N_CUTS
#define N_CUTS 0
#endif
extern "C" void kernel_launch(void* const* d_in, const int* in_sizes, int n_in, void* d_out, int out_size, void* d_ws, size_t ws_size, hipStream_t stream) {
    static int grid = 0;
    if (grid == 0) {
        if (n_in != 15 || out_size != (int)O_END || ws_size < WS_END) { fprintf(stderr, "kernel_launch: unexpected shapes n_in %d out %d ws %zu (need %zu)\n", n_in, out_size, ws_size, (size_t)WS_END); grid = -1; return; }
        int dev = 0, cus = 0, per_cu = 0;
        if (hipGetDevice(&dev) != hipSuccess || hipDeviceGetAttribute(&cus, hipDeviceAttributeMultiprocessorCount, dev) != hipSuccess) { grid = -1; return; }
        if (hipFuncSetAttribute((const void*)fwd, hipFuncAttributeMaxDynamicSharedMemorySize, LDS_BYTES) != hipSuccess) { fprintf(stderr, "kernel_launch: hipFuncSetAttribute failed\n"); grid = -1; return; }
        if (hipOccupancyMaxActiveBlocksPerMultiprocessor(&per_cu, (const void*)fwd, NTHR, LDS_BYTES) != hipSuccess || per_cu < 1) fprintf(stderr, "kernel_launch: occupancy query says %d\n", per_cu);
        (void)hipGetLastError();
        grid = cus;
    }
    if (grid < 0) return;
    (void)hipMemsetAsync((char*)d_ws + WS_CTL, 0, CTL_ZERO_BYTES, stream);
    Args a{};
    for (int i = 0; i < 15; ++i) a.in[i] = (const float*)d_in[i];
    a.out = (float*)d_out; a.ws = (unsigned char*)d_ws;
#if N_CUTS == 0
    a.ph_lo = 0; a.ph_hi = N_PHASES;
    hipLaunchKernelGGL(fwd, dim3(grid), dim3(NTHR), LDS_BYTES, stream, a);
#else
    for (int p = 0; p < N_PHASES; ++p) { a.ph_lo = p; a.ph_hi = p + 1; hipLaunchKernelGGL(fwd, dim3(grid), dim3(NTHR), LDS_BYTES, stream, a); }
#endif
}
```
